# Optimizing an MI355X kernel written in HIP

```python
import math
import jax, jax.numpy as jnp
from jax import lax
import numpy as np

D_MODEL = 1024
BATCH = 2
SEQ = 16384
DEPTH = 4

N_MIXERS = 4
D_FF = 2816
N_MOD = 9
EPS = 1e-6
Q_BLOCK = 128
GRID_W = 64

POOL_WINDOWS = (2, 4, 8, 16)
N_POOL = len(POOL_WINDOWS)
POOL_GROUP = D_MODEL // N_POOL

DIFF_HEADS = 8
DIFF_HEAD_DIM = D_MODEL // DIFF_HEADS // 2
DIFF_V_DIM = 2 * DIFF_HEAD_DIM
ROPE_THETA = 500000.0
ROT_DIM = DIFF_HEAD_DIM // 4

GQA_HEADS = 8
GQA_KV_HEADS = 2
GQA_HEAD_DIM = D_MODEL // GQA_HEADS
GQA_GROUP = GQA_HEADS // GQA_KV_HEADS
GQA_Q_DIM = GQA_HEADS * GQA_HEAD_DIM
GQA_KV_DIM = GQA_KV_HEADS * GQA_HEAD_DIM
AXIAL_THETA = 10000.0
AXIAL_DIM = GQA_HEAD_DIM // 2

CONV_WIDTH = 3

kernel_name = "hybrid_interleaved_adaln_encoder"


def rms_norm(x, g):
    xf = x.astype(jnp.float32)
    y = xf * lax.rsqrt(jnp.mean(xf * xf, axis=-1, keepdims=True) + EPS)
    return (y * g.astype(jnp.float32)).astype(x.dtype)


def modulate(h, shift, scale):
    return h * (1 + scale) + shift


def swiglu(h, w_gu, w_down):
    g, u = jnp.split(h @ w_gu, 2, axis=-1)
    return (jax.nn.silu(g) * u) @ w_down


def rope_tables(pos, dim, theta):
    inv = 1.0 / (theta ** (jnp.arange(0, dim, 2, dtype=jnp.float32) / dim))
    ang = pos.astype(jnp.float32)[:, None] * inv[None, :]
    return jnp.cos(ang), jnp.sin(ang)


def rope(x, cos, sin):
    half = x.shape[-1] // 2
    xf = x.astype(jnp.float32)
    x1, x2 = xf[..., :half], xf[..., half:]
    c = cos[None, :, None, :]
    s = sin[None, :, None, :]
    return jnp.concatenate([x1 * c - x2 * s, x2 * c + x1 * s], axis=-1).astype(x.dtype)


def sweep_query_blocks(fn, q):
    b, s = q.shape[:2]
    nblk = s // Q_BLOCK
    qb = jnp.moveaxis(q.reshape((b, nblk, Q_BLOCK) + q.shape[2:]), 1, 0)
    out = jnp.moveaxis(lax.map(fn, qb), 0, 1)
    return out.reshape((b, s) + out.shape[3:])


def pool_mixer(h, pool_w, pool_scale):
    b, s, d = h.shape
    cs = jnp.concatenate([jnp.zeros((b, 1, d), jnp.float32),
                          jnp.cumsum(h.astype(jnp.float32), axis=1)], axis=1)
    t = jnp.arange(s)
    diffs = []
    for g, win in enumerate(POOL_WINDOWS):
        lo = jnp.clip(t - win // 2, 0, s)
        hi = jnp.clip(t + win // 2, 0, s)
        csg = cs[..., g * POOL_GROUP:(g + 1) * POOL_GROUP]
        mean = (jnp.take(csg, hi, axis=1) - jnp.take(csg, lo, axis=1)) / (hi - lo).astype(jnp.float32)[None, :, None]
        diffs.append(mean.astype(h.dtype) - h[..., g * POOL_GROUP:(g + 1) * POOL_GROUP])
    dgrp = jnp.stack(diffs, axis=2)
    y = jnp.einsum('bsgc,gce->bsge', dgrp, pool_w).reshape(b, s, d)
    return y * pool_scale


def diff_attention(h, w_qkv, lam, subln_g, w_o, cos, sin, layer_idx):
    b, s, d = h.shape
    q, k, v = jnp.split(h @ w_qkv, 3, axis=-1)
    q = q.reshape(b, s, 2 * DIFF_HEADS, DIFF_HEAD_DIM)
    k = k.reshape(b, s, 2 * DIFF_HEADS, DIFF_HEAD_DIM)
    v = v.reshape(b, s, DIFF_HEADS, DIFF_V_DIM)
    q = jnp.concatenate([rope(q[..., :ROT_DIM], cos, sin), q[..., ROT_DIM:]], axis=-1)
    k = jnp.concatenate([rope(k[..., :ROT_DIM], cos, sin), k[..., ROT_DIM:]], axis=-1)
    q = (q * DIFF_HEAD_DIM ** -0.5).reshape(b, s, DIFF_HEADS, 2, DIFF_HEAD_DIM)
    k = k.reshape(b, s, DIFF_HEADS, 2, DIFF_HEAD_DIM)
    lam_init = 0.8 - 0.6 * math.exp(-0.3 * layer_idx)
    lf = lam.astype(jnp.float32)
    lam_full = jnp.exp(jnp.sum(lf[0] * lf[1])) - jnp.exp(jnp.sum(lf[2] * lf[3])) + lam_init

    def block(qb):
        sc = jnp.einsum('bqhcd,bkhcd->bhcqk', qb, k, preferred_element_type=jnp.float32)
        p = jax.nn.softmax(sc, axis=-1)
        a = p[:, :, 0] - lam_full * p[:, :, 1]
        return jnp.einsum('bhqk,bkhe->bqhe', a.astype(v.dtype), v)

    o = sweep_query_blocks(block, q)
    o = rms_norm(o, subln_g) * (1 - lam_init)
    return o.reshape(b, s, d) @ w_o


def gqa_axial_attention(h, w_qkv, q_norm_g, k_norm_g, w_o, cos_r, sin_r, cos_c, sin_c):
    b, s, d = h.shape
    qkv = h @ w_qkv
    q = qkv[..., :GQA_Q_DIM].reshape(b, s, GQA_HEADS, GQA_HEAD_DIM)
    k = qkv[..., GQA_Q_DIM:GQA_Q_DIM + GQA_KV_DIM].reshape(b, s, GQA_KV_HEADS, GQA_HEAD_DIM)
    v = qkv[..., GQA_Q_DIM + GQA_KV_DIM:].reshape(b, s, GQA_KV_HEADS, GQA_HEAD_DIM)
    q = rms_norm(q, q_norm_g)
    k = rms_norm(k, k_norm_g)

    def axial(t):
        return jnp.concatenate([rope(t[..., :AXIAL_DIM], cos_r, sin_r),
                                rope(t[..., AXIAL_DIM:], cos_c, sin_c)], axis=-1)

    q = (axial(q) * GQA_HEAD_DIM ** -0.5).reshape(b, s, GQA_KV_HEADS, GQA_GROUP, GQA_HEAD_DIM)
    k = axial(k)

    def block(qb):
        sc = jnp.einsum('bqgrd,bkgd->bgrqk', qb, k, preferred_element_type=jnp.float32)
        p = jax.nn.softmax(sc, axis=-1)
        return jnp.einsum('bgrqk,bkgd->bqgrd', p.astype(v.dtype), v)

    o = sweep_query_blocks(block, q)
    return o.reshape(b, s, d) @ w_o


def short_conv_mixer(h, w_in, w_conv, w_out):
    d = h.shape[-1]
    gb, gc, u = jnp.split(h @ w_in, 3, axis=-1)
    z = gc * u
    zc = lax.conv_general_dilated(z, w_conv[:, None, :], window_strides=(1,),
                                  padding=[((CONV_WIDTH - 1) // 2, (CONV_WIDTH - 1) // 2)],
                                  dimension_numbers=('NWC', 'WIO', 'NWC'),
                                  feature_group_count=d)
    return (gb * zc) @ w_out


def setup_inputs(seed: int = 0) -> dict:
    key = jax.random.key(seed)
    ks = jax.random.split(key, 24)

    def nrm(k, shape, scale):
        return jax.random.normal(k, shape, jnp.float32) * scale

    D = D_MODEL
    return {
        "x": nrm(ks[0], (BATCH, SEQ, D), 1.0),
        "c": nrm(ks[1], (BATCH, D), 1.0),
        "mod_w": nrm(ks[2], (DEPTH, D, N_MOD * D), 0.5 * D ** -0.5),
        "mod_b": nrm(ks[3], (DEPTH, N_MOD * D), 0.02),
        "norm_g": 1.0 + nrm(ks[4], (DEPTH, 3, D), 0.1),
        "ffn_w_gu": nrm(ks[5], (DEPTH, 2, D, 2 * D_FF), D ** -0.5),
        "ffn_w_down": nrm(ks[6], (DEPTH, 2, D_FF, D), D_FF ** -0.5),
        "pool_w": nrm(ks[7], (N_POOL, POOL_GROUP, POOL_GROUP), POOL_GROUP ** -0.5),
        "pool_scale": 1.0 + nrm(ks[8], (D,), 0.1),
        "diff_w_qkv": nrm(ks[9], (D, 3 * D), D ** -0.5),
        "diff_lambda": nrm(ks[10], (4, DIFF_HEAD_DIM), 0.1),
        "diff_subln_g": 1.0 + nrm(ks[11], (DIFF_V_DIM,), 0.1),
        "diff_w_o": nrm(ks[12], (D, D), D ** -0.5),
        "gqa_w_qkv": nrm(ks[13], (D, GQA_Q_DIM + 2 * GQA_KV_DIM), D ** -0.5),
        "gqa_q_norm_g": 1.0 + nrm(ks[14], (GQA_HEAD_DIM,), 0.1),
        "gqa_k_norm_g": 1.0 + nrm(ks[15], (GQA_HEAD_DIM,), 0.1),
        "gqa_w_o": nrm(ks[16], (D, D), D ** -0.5),
        "conv_w_in": nrm(ks[17], (D, 3 * D), D ** -0.5),
        "conv_w": nrm(ks[18], (CONV_WIDTH, D), CONV_WIDTH ** -0.5),
        "conv_w_out": nrm(ks[19], (D, D), D ** -0.5),
        "final_g": 1.0 + nrm(ks[20], (D,), 0.1),
    }


def reference(x, c, mod_w, mod_b, norm_g, ffn_w_gu, ffn_w_down, pool_w, pool_scale,
              diff_w_qkv, diff_lambda, diff_subln_g, diff_w_o,
              gqa_w_qkv, gqa_q_norm_g, gqa_k_norm_g, gqa_w_o,
              conv_w_in, conv_w, conv_w_out, final_g):
    s = x.shape[1]
    t = jnp.arange(s)
    cos1, sin1 = rope_tables(t, ROT_DIM, ROPE_THETA)
    rows = s // GRID_W
    row_pos = jnp.broadcast_to(jnp.arange(rows)[:, None], (rows, GRID_W)).reshape(-1)
    col_pos = jnp.broadcast_to(jnp.arange(GRID_W)[None, :], (rows, GRID_W)).reshape(-1)
    cos_r, sin_r = rope_tables(row_pos, AXIAL_DIM, AXIAL_THETA)
    cos_c, sin_c = rope_tables(col_pos, AXIAL_DIM, AXIAL_THETA)

    c_act = jax.nn.silu(c)
    for i in range(DEPTH):
        mod = (c_act @ mod_w[i] + mod_b[i])[:, None, :]
        sh0, sc0, g0, sh1, sc1, g1, sh2, sc2, g2 = jnp.split(mod, N_MOD, axis=-1)

        h = modulate(rms_norm(x, norm_g[i, 0]), sh0, sc0)
        x = x + 0.5 * g0 * swiglu(h, ffn_w_gu[i, 0], ffn_w_down[i, 0])

        h = modulate(rms_norm(x, norm_g[i, 1]), sh1, sc1)
        kind = i % N_MIXERS
        if kind == 0:
            y = pool_mixer(h, pool_w, pool_scale)
        elif kind == 1:
            y = diff_attention(h, diff_w_qkv, diff_lambda, diff_subln_g, diff_w_o, cos1, sin1, i)
        elif kind == 2:
            y = gqa_axial_attention(h, gqa_w_qkv, gqa_q_norm_g, gqa_k_norm_g, gqa_w_o,
                                    cos_r, sin_r, cos_c, sin_c)
        else:
            y = short_conv_mixer(h, conv_w_in, conv_w, conv_w_out)
        x = x + g1 * y

        h = modulate(rms_norm(x, norm_g[i, 2]), sh2, sc2)
        x = x + 0.5 * g2 * swiglu(h, ffn_w_gu[i, 1], ffn_w_down[i, 1])

    return rms_norm(x, final_g)
```

```cpp
#include <hip/hip_runtime.h>
#include <hip/hip_bf16.h>
#include <hip/hip_cooperative_groups.h>
#include <cstdio>
#include <cstdint>
namespace cg = cooperative_groups;

#ifndef MK_ONE_LAUNCH
#define MK_ONE_LAUNCH 1
#endif

constexpr int D = 1024, BATCH = 2, SEQ = 16384, M = BATCH * SEQ, DEPTH = 4, DFF = 2816, NMOD = 9;
constexpr float EPS = 1e-6f;
constexpr float LAM_INIT = 0.35550906759096934f;
constexpr int NWAVES = 8, NTHR = 512;

__constant__ float INV1[8] = {1.000000000e+00f, 1.939227581e-01f, 3.760603070e-02f, 7.292665076e-03f, 1.414213446e-03f, 2.742481884e-04f, 5.318296462e-05f, 1.031338525e-05f};
__constant__ float INV2[32] = {1.000000000e+00f, 7.498942018e-01f, 5.623413324e-01f, 4.216965139e-01f, 3.162277639e-01f, 2.371373922e-01f, 1.778279394e-01f, 1.333521456e-01f, 1.000000015e-01f, 7.498941571e-02f, 5.623412877e-02f, 4.216964915e-02f, 3.162277862e-02f, 2.371373586e-02f, 1.778279431e-02f, 1.333521493e-02f, 9.999999776e-03f, 7.498942316e-03f, 5.623413250e-03f, 4.216964822e-03f, 3.162277862e-03f, 2.371373819e-03f, 1.778279431e-03f, 1.333521446e-03f, 1.000000047e-03f, 7.498941850e-04f, 5.623413017e-04f, 4.216965463e-04f, 3.162277862e-04f, 2.371373848e-04f, 1.778279402e-04f, 1.333521504e-04f};

constexpr size_t MiB = 1u << 20;
constexpr size_t WS_MODV  = 0;
constexpr size_t WS_ROPE1 = 1 * MiB;
constexpr size_t WS_AXR   = 2 * MiB;
constexpr size_t WS_AXC   = 2 * MiB + 65536;
constexpr size_t WS_BAR   = 3 * MiB;
constexpr size_t WS_WGU   = 4 * MiB;
constexpr size_t SZ_WGU1  = (size_t)2 * DFF * D * 2;
constexpr size_t WS_WDN   = WS_WGU + 8 * SZ_WGU1;
constexpr size_t SZ_WDN1  = (size_t)D * DFF * 2;
constexpr size_t WS_WPOOL = WS_WDN + 8 * SZ_WDN1;
constexpr size_t WS_WDQKV = WS_WPOOL + (size_t)1024 * 256 * 2;
constexpr size_t WS_WDO   = WS_WDQKV + (size_t)3072 * 1024 * 2;
constexpr size_t WS_WGQKV = WS_WDO + (size_t)1024 * 1024 * 2;
constexpr size_t WS_WGO   = WS_WGQKV + (size_t)1536 * 1024 * 2;
constexpr size_t WS_WCIN  = WS_WGO + (size_t)1024 * 1024 * 2;
constexpr size_t WS_WCOUT = WS_WCIN + (size_t)3072 * 1024 * 2;
constexpr size_t WS_XN    = ((WS_WCOUT + (size_t)1024 * 1024 * 2 + MiB - 1) / MiB) * MiB;
constexpr size_t SZ_ACT1K = (size_t)M * D * 2;
constexpr size_t WS_ACT   = WS_XN + SZ_ACT1K;
constexpr size_t WS_Q     = WS_ACT, WS_K = WS_ACT + SZ_ACT1K;
constexpr size_t WS_V     = WS_ACT + (size_t)M * DFF * 2;
constexpr size_t WS_AO    = WS_V + SZ_ACT1K;
constexpr size_t WS_S0    = WS_AO + SZ_ACT1K;
constexpr size_t WS_XB    = WS_S0 + (size_t)256 * 256 * 128 * 4;
constexpr size_t WS_END   = WS_XB + SZ_ACT1K;

struct Args { const float* in[21]; float* out; unsigned char* ws; int ph_lo, ph_hi; };
typedef const __attribute__((address_space(4))) Args* KArgs;

#define LAS __attribute__((address_space(3)))
typedef unsigned short bf16_t;
typedef unsigned v4u __attribute__((ext_vector_type(4)));
typedef unsigned v2u __attribute__((ext_vector_type(2)));
typedef float f32x4 __attribute__((ext_vector_type(4)));
typedef float f32x2 __attribute__((ext_vector_type(2)));
#define LDS_WAIT() asm volatile("s_waitcnt lgkmcnt(0)" ::: "memory")
__device__ __forceinline__ unsigned cvt_pk_bf16(float lo, float hi) { unsigned r; asm volatile("v_cvt_pk_bf16_f32 %0, %1, %2" : "=v"(r) : "v"(lo), "v"(hi)); return r; }
typedef _Float16 h16x4 __attribute__((ext_vector_type(4)));
typedef _Float16 h16x8 __attribute__((ext_vector_type(8)));
typedef float f32x8 __attribute__((ext_vector_type(8)));
__device__ __forceinline__ f32x4 half4_to_f32(v2u w) { return __builtin_convertvector(__builtin_bit_cast(h16x4, w), f32x4); }
__device__ __forceinline__ v2u f32_to_half4(f32x4 v) { return __builtin_bit_cast(v2u, __builtin_convertvector(v, h16x4)); }
__device__ __forceinline__ float bf_lo(unsigned w) { return __uint_as_float(w << 16); }
__device__ __forceinline__ float bf_hi(unsigned w) { return __uint_as_float(w & 0xffff0000u); }
__device__ __forceinline__ float wave_sum(float v) {
#pragma unroll
    for (int o = 1; o < 64; o <<= 1) v += __shfl_xor(v, o);
    return v;
}
__device__ __forceinline__ float silu_f(float g) { return g * __builtin_amdgcn_rcpf(1.0f + __builtin_amdgcn_exp2f(-1.4426950408889634f * g)); }
__device__ __forceinline__ void sincos_acc(float angf, float& c, float& s) {
    const double x = (double)angf;
    const double k = __builtin_rint(x * 0.63661977236758134308);
    double y = __builtin_fma(-k, 1.57079632679489655800, x); y = __builtin_fma(-k, 6.12323399573676603587e-17, y);
    const int q = (int)((long long)k & 3LL);
    const double y2 = y * y;
    const double sp = y * (1.0 + y2 * (-1.0 / 6 + y2 * (1.0 / 120 + y2 * (-1.0 / 5040 + y2 * (1.0 / 362880 + y2 * (-1.0 / 39916800 + y2 * (1.0 / 6227020800.0)))))));
    const double cp = 1.0 + y2 * (-0.5 + y2 * (1.0 / 24 + y2 * (-1.0 / 720 + y2 * (1.0 / 40320 + y2 * (-1.0 / 3628800 + y2 * (1.0 / 479001600.0 + y2 * (-1.0 / 87178291200.0)))))));
    const double ss = (q == 0) ? sp : (q == 1) ? cp : (q == 2) ? -sp : -cp;
    const double cc = (q == 0) ? cp : (q == 1) ? -sp : (q == 2) ? -cp : sp;
    c = (float)cc; s = (float)ss;
}


namespace pg8 {
#define PG8_LAS __attribute__((address_space(3)))
typedef unsigned short bf16_t;
typedef short bf16x8 __attribute__((ext_vector_type(8)));
typedef float f32x4 __attribute__((ext_vector_type(4)));
typedef unsigned u32x4 __attribute__((ext_vector_type(4)));
constexpr int BM = 256, BK = 64, HALF = 128, HTB = HALF * BK * 2  , STAGE_BYTES = 8 * HTB, NXCD = 8, WGM = 8;

__host__ __device__ __forceinline__ int lds_byte(int r, int c) { const int st = (r >> 4) * 2 + (c >> 5), rr = r & 15, cc = c & 31, ob = rr * 64 + cc * 2; return st * 1024 + (ob ^ (((ob >> 9) & 1) << 5)); }
__host__ __device__ __forceinline__ void stage_rc(int b, int& R, int& C) { const int st = b / 1024, sb = b % 1024, swz = sb ^ (((sb >> 9) & 1) << 5); R = (st >> 1) * 16 + swz / 64; C = (st & 1) * 32 + (swz % 64) / 2; }
__host__ __device__ __forceinline__ int perm32(int rho) { const int n = rho >> 4, i = rho & 15; return 8 * (i >> 2) + 4 * n + (i & 3); }

struct Unit { int pm, pn; };
struct Gemm { const bf16_t* A; const bf16_t* Bt; int M, N, K, lda, ldb, acolb; };

struct StaticOrder {
    int nM, nN, nwg, G, c;
    __host__ __device__ void init(int M, int N, int G_, int c_) { nM = M / BM; nN = N / BM; nwg = nM * nN; G = G_; c = c_; }
    __host__ __device__ bool next(int i, Unit& u) const {
        const long L = (long)i * G + c; if (L >= nwg) return false;
        int wgid = (int)L; { const int q = nwg / NXCD, r = nwg % NXCD, xcd = wgid % NXCD, off = wgid / NXCD; wgid = (xcd < r ? xcd * (q + 1) : r * (q + 1) + (xcd - r) * q) + off; }
        const int nig = WGM * nN, gid = wgid / nig, fm = gid * WGM, gsz = (nM - fm) < WGM ? (nM - fm) : WGM;
        u.pm = fm + ((wgid % nig) % gsz); u.pn = (wgid % nig) / gsz; return true;
    }
    __device__ __forceinline__ void a_ready(const Unit&) const {}
    __device__ __forceinline__ void done(const Unit&) const {}
};

__device__ __forceinline__ unsigned cvt_pk_bf16(float lo, float hi) { unsigned r; asm volatile("v_cvt_pk_bf16_f32 %0, %1, %2" : "=v"(r) : "v"(lo), "v"(hi)); return r; }
__device__ __forceinline__ float silu_f(float g) { return g * __builtin_amdgcn_rcpf(1.0f + __builtin_amdgcn_exp2f(-1.4426950408889634f * g)); }
__device__ __forceinline__ u32x4 pack8(const f32x4 v0, const f32x4 v1) { u32x4 w; w.x = cvt_pk_bf16(v0[0], v0[1]); w.y = cvt_pk_bf16(v0[2], v0[3]); w.z = cvt_pk_bf16(v1[0], v1[1]); w.w = cvt_pk_bf16(v1[2], v1[3]); return w; }

typedef _Float16 h16x8 __attribute__((ext_vector_type(8))); typedef float f32x8 __attribute__((ext_vector_type(8)));
__device__ __forceinline__ void unpack8(const u32x4 w, f32x4& a, f32x4& b) { const f32x8 f = __builtin_convertvector(__builtin_bit_cast(h16x8, w), f32x8);
    a = (f32x4){f[0], f[1], f[2], f[3]}; b = (f32x4){f[4], f[5], f[6], f[7]}; }
__device__ __forceinline__ u32x4 pack8h(const f32x4 a, const f32x4 b) { const f32x8 f = {a[0], a[1], a[2], a[3], b[0], b[1], b[2], b[3]}; return __builtin_bit_cast(u32x4, __builtin_convertvector(f, h16x8)); }
struct EpiRes {
    static constexpr bool PERM = true, AFTER_DRAIN = false;
    const void* xin; int xin_f32; bf16_t* xout; const float* gate; const float* cscale; float mul;
    __device__ __forceinline__ void operator()(const f32x4 (&acc)[2][2][4][2], const Unit& u, int wr, int wc, int fr, int fq) const {
        const int b = u.pm >> 6;
        const float* gb = gate + (size_t)b * 9216;
        const int col0 = u.pn * BM + wc * 32 + 8 * fq;
        f32x4 gv[2][2];
#pragma unroll
        for (int bj = 0; bj < 2; ++bj)
#pragma unroll
            for (int n = 0; n < 2; ++n) { f32x4 g = *(const f32x4*)(gb + col0 + bj * HALF + 4 * n) * mul;
                if (cscale) g = g * *(const f32x4*)(cscale + col0 + bj * HALF + 4 * n); gv[bj][n] = g; }
#pragma unroll
        for (int ai = 0; ai < 2; ++ai)
#pragma unroll
            for (int m = 0; m < 4; ++m) { const size_t off = (size_t)(u.pm * BM + ai * HALF + wr * 64 + m * 16 + fr) * 1024 + col0;
#pragma unroll
                for (int bj = 0; bj < 2; ++bj) { f32x4 x0, x1;
                    if (xin_f32) { const float* p = (const float*)xin + off + bj * HALF; x0 = *(const f32x4*)p; x1 = *(const f32x4*)(p + 4); }
                    else unpack8(*(const u32x4*)((const bf16_t*)xin + off + bj * HALF), x0, x1);
                    *(u32x4*)(xout + off + bj * HALF) = pack8h(x0 + gv[bj][0] * acc[ai][bj][m][0], x1 + gv[bj][1] * acc[ai][bj][m][1]); }
                if (m & 1) asm volatile("" ::: "memory"); }
    }
};
struct EpiSwiglu {
    static constexpr bool PERM = true, AFTER_DRAIN = false;
    bf16_t* O; int ldc;
    __device__ __forceinline__ void operator()(const f32x4 (&acc)[2][2][4][2], const Unit& u, int wr, int wc, int fr, int fq) const {
        const int col0 = u.pn * HALF + wc * 32 + 8 * fq;
#pragma unroll
        for (int ai = 0; ai < 2; ++ai)
#pragma unroll
            for (int m = 0; m < 4; ++m) { bf16_t* p = O + (size_t)(u.pm * BM + ai * HALF + wr * 64 + m * 16 + fr) * ldc + col0;
                f32x4 v0, v1;
#pragma unroll
                for (int e = 0; e < 4; ++e) { v0[e] = silu_f(acc[ai][0][m][0][e]) * acc[ai][1][m][0][e]; v1[e] = silu_f(acc[ai][0][m][1][e]) * acc[ai][1][m][1][e]; }
                *(u32x4*)p = pack8(v0, v1); }
    }
};
struct EpiConvIn {
    static constexpr bool PERM = true, AFTER_DRAIN = false;
    bf16_t* Z; bf16_t* GB;
    __device__ __forceinline__ void operator()(const f32x4 (&acc)[2][2][4][2], const Unit& u, int wr, int wc, int fr, int fq) const {
        if (u.pn < 8) {
            const int col0 = u.pn * HALF + wc * 32 + 8 * fq;
#pragma unroll
            for (int ai = 0; ai < 2; ++ai)
#pragma unroll
                for (int m = 0; m < 4; ++m) { bf16_t* p = Z + (size_t)(u.pm * BM + ai * HALF + wr * 64 + m * 16 + fr) * 1024 + col0;
                    *(u32x4*)p = pack8(acc[ai][0][m][0] * acc[ai][1][m][0], acc[ai][0][m][1] * acc[ai][1][m][1]); }
        } else {
            const int col0 = (u.pn - 8) * BM + wc * 32 + 8 * fq;
#pragma unroll
            for (int ai = 0; ai < 2; ++ai)
#pragma unroll
                for (int m = 0; m < 4; ++m) { bf16_t* p = GB + (size_t)(u.pm * BM + ai * HALF + wr * 64 + m * 16 + fr) * 1024 + col0;
#pragma unroll
                    for (int bj = 0; bj < 2; ++bj) *(u32x4*)(p + bj * HALF) = pack8(acc[ai][bj][m][0], acc[ai][bj][m][1]); }
        }
    }
};
struct EpiGqaQkv {
    static constexpr bool PERM = true, AFTER_DRAIN = false;
    unsigned char* ws;
    __device__ __forceinline__ void operator()(const f32x4 (&acc)[2][2][4][2], const Unit& u, int wr, int wc, int fr, int fq) const {
        const size_t boff = u.pn < 4 ? WS_Q : (u.pn == 4 ? WS_K : WS_V); bf16_t* base = (bf16_t*)(ws + boff); const int ld = u.pn < 4 ? 1024 : 256; const int colt = u.pn < 4 ? u.pn * BM : 0;
        const int col0 = colt + wc * 32 + 8 * fq;
#pragma unroll
        for (int ai = 0; ai < 2; ++ai)
#pragma unroll
            for (int m = 0; m < 4; ++m) { bf16_t* p = base + (size_t)(u.pm * BM + ai * HALF + wr * 64 + m * 16 + fr) * ld + col0;
#pragma unroll
                for (int bj = 0; bj < 2; ++bj) *(u32x4*)(p + bj * HALF) = pack8(acc[ai][bj][m][0], acc[ai][bj][m][1]); }
    }
};
struct EpiDiffQkv {
    static constexpr bool PERM = true, AFTER_DRAIN = false;
    unsigned char* ws; const float* rope;
    __device__ __forceinline__ void operator()(const f32x4 (&acc)[2][2][4][2], const Unit& u, int wr, int wc, int fr, int fq) const {
        const int t = u.pn >> 2; const size_t boff = t == 0 ? WS_Q : (t == 1 ? WS_K : WS_V); bf16_t* base = (bf16_t*)(ws + boff);
        const int col0 = (u.pn & 3) * BM + wc * 32 + 8 * fq;
        const bool rot = ((wc & 1) == 0) && (fq < 2);
#pragma unroll
        for (int ai = 0; ai < 2; ++ai)
#pragma unroll
            for (int m = 0; m < 4; ++m) { const int row = u.pm * BM + ai * HALF + wr * 64 + m * 16 + fr; bf16_t* p = base + (size_t)row * 1024 + col0;
                f32x4 cs0 = {1.f, 1.f, 1.f, 1.f}, cs1 = cs0, sn0 = {0.f, 0.f, 0.f, 0.f}, sn1 = sn0;
                if (t < 2 && rot) { const float* rp = rope + (size_t)(row & (SEQ - 1)) * 16; cs0 = *(const f32x4*)rp; cs1 = *(const f32x4*)(rp + 4); sn0 = *(const f32x4*)(rp + 8); sn1 = *(const f32x4*)(rp + 12);
                    if (fq == 0) { sn0 = -sn0; sn1 = -sn1; } }
#pragma unroll
                for (int bj = 0; bj < 2; ++bj) { f32x4 v0 = acc[ai][bj][m][0], v1 = acc[ai][bj][m][1];
                    if (t < 2) { f32x4 p0, p1;
#pragma unroll
                        for (int e = 0; e < 4; ++e) { p0[e] = __shfl_xor(v0[e], 16); p1[e] = __shfl_xor(v1[e], 16); }
                        v0 = v0 * cs0 + p0 * sn0; v1 = v1 * cs1 + p1 * sn1;
                        if (t == 0) { v0 = v0 * 0.18033688011112042f; v1 = v1 * 0.18033688011112042f; } }
                    *(u32x4*)(p + bj * HALF) = pack8(v0, v1); } }
    }
};

template <class Epi, class Sched, bool ALIGN_EPI = false, bool SP2 = false>
__device__ __forceinline__ void gemm_phase(PG8_LAS unsigned char* lds, const Gemm g, const Sched& S, const Epi& E) {
    int tid_ = threadIdx.x; asm volatile("" : "+v"(tid_)); const int tid = tid_, wid = __builtin_amdgcn_readfirstlane(tid >> 6), lane = tid & 63, wr = wid >> 2, wc = wid & 3, fr = lane & 15, fq = lane >> 4;
    const int K = g.K, nt = K / BK;
    unsigned voffA[2], voffB[2];
#pragma unroll
    for (int i = 0; i < 2; ++i) { int R, C; stage_rc(tid * 16 + i * 8192, R, C); const int Rb = Epi::PERM ? ((R & ~31) + perm32(R & 31)) : R;
        voffA[i] = (unsigned)(R * g.lda + C) * 2u; voffB[i] = (unsigned)(Rb * g.ldb + C) * 2u; }
    const size_t kstep = (size_t)(BK * 2);
    const size_t hstepA = (size_t)HALF * g.lda * 2, hstepB = (size_t)HALF * g.ldb * 2;
    const size_t tstepA = 2 * hstepA, tstepB = 2 * hstepB;
    const unsigned ldsw = (unsigned)wid * 1024u;
    const int aoff = lds_byte(wr * 64 + fr, fq * 8), boff = lds_byte(wc * 32 + fr, fq * 8);
#define PG8_SA(b, h) (((b) * 2 + (h)) * HTB)
#define PG8_SB(b, h) ((4 + (b) * 2 + (h)) * HTB)
#define PG8_STAGE(bufoff, gbase, voff) do { _Pragma("unroll") for (int _i = 0; _i < 2; ++_i) \
        __builtin_amdgcn_global_load_lds((const unsigned*)((const char*)(gbase) + (voff)[_i]), (PG8_LAS unsigned*)(lds + (bufoff) + ldsw + _i * 8192), 16, 0, 0); } while (0)
#define PG8_LDA(dst, b, h) do { _Pragma("unroll") for (int m = 0; m < 4; ++m) _Pragma("unroll") for (int k = 0; k < 2; ++k) dst[m][k] = *(const PG8_LAS bf16x8*)(lds + PG8_SA(b, h) + aoff + m * 2048 + k * 1024); } while (0)
#define PG8_LDB(dst, b, h) do { _Pragma("unroll") for (int n = 0; n < 2; ++n) _Pragma("unroll") for (int k = 0; k < 2; ++k) dst[n][k] = *(const PG8_LAS bf16x8*)(lds + PG8_SB(b, h) + boff + n * 2048 + k * 1024); } while (0)
#define PG8_MMA(ai, bj, At, Bt) do { __builtin_amdgcn_s_setprio(1); _Pragma("unroll") for (int m = 0; m < 4; ++m) _Pragma("unroll") for (int n = 0; n < 2; ++n) _Pragma("unroll") for (int k = 0; k < 2; ++k) \
        acc[ai][bj][m][n] = __builtin_amdgcn_mfma_f32_16x16x32_bf16(Bt[n][k], At[m][k], acc[ai][bj][m][n], 0, 0, 0); __builtin_amdgcn_s_setprio(0); } while (0)
#define PG8_WAIT_V(n) asm volatile("s_waitcnt vmcnt(" #n ")" ::: "memory")
#define PG8_WAIT_L(n) asm volatile("s_waitcnt lgkmcnt(" #n ")" ::: "memory")
#define PG8_BAR __builtin_amdgcn_s_barrier()
#define PG8_SCHED __builtin_amdgcn_sched_barrier(0)
    Unit cur, nxt; int ui = 0;
    if (!S.next(0, cur)) return;
    f32x4 acc[2][2][4][2];
#pragma unroll
    for (int a = 0; a < 2; ++a)
#pragma unroll
        for (int b = 0; b < 2; ++b)
#pragma unroll
            for (int m = 0; m < 4; ++m)
#pragma unroll
                for (int n = 0; n < 2; ++n) acc[a][b][m][n] = (f32x4){0.f, 0.f, 0.f, 0.f};
    bf16x8 At[4][2], B0[2][2], B1[2][2];
    const char* cA = (const char*)g.A + (size_t)cur.pm * tstepA + (size_t)cur.pn * g.acolb; const char* cB = (const char*)g.Bt + (size_t)cur.pn * tstepB;
    S.a_ready(cur);
    if constexpr (SP2) {
        PG8_STAGE(PG8_SB(0, 0), cB, voffB); PG8_STAGE(PG8_SB(0, 1), cB + hstepB, voffB); PG8_STAGE(PG8_SA(0, 0), cA, voffA); PG8_STAGE(PG8_SA(0, 1), cA + hstepA, voffA);
        if (wr == 1) PG8_BAR;
        PG8_WAIT_V(2); PG8_BAR;
        PG8_STAGE(PG8_SB(1, 0), cB + kstep, voffB); PG8_STAGE(PG8_SA(1, 0), cA + kstep, voffA); PG8_STAGE(PG8_SB(1, 1), cB + hstepB + kstep, voffB);
        PG8_WAIT_V(6); PG8_BAR;
    } else {
        PG8_STAGE(PG8_SB(0, 0), cB, voffB); PG8_STAGE(PG8_SA(0, 0), cA, voffA); PG8_STAGE(PG8_SB(0, 1), cB + hstepB, voffB); PG8_STAGE(PG8_SA(0, 1), cA + hstepA, voffA);
        if (wr == 1) PG8_BAR;
        PG8_WAIT_V(4); PG8_BAR;
        PG8_STAGE(PG8_SB(1, 0), cB + kstep, voffB); PG8_STAGE(PG8_SA(1, 0), cA + kstep, voffA); PG8_STAGE(PG8_SB(1, 1), cB + hstepB + kstep, voffB);
        PG8_WAIT_V(6); PG8_BAR;
    }
    for (;;) {
        const bool has_next = S.next(ui + 1, nxt);
        const char* nA = has_next ? (const char*)g.A + (size_t)nxt.pm * tstepA + (size_t)nxt.pn * g.acolb : cA; const char* nB = has_next ? (const char*)g.Bt + (size_t)nxt.pn * tstepB : cB;
        for (int t = 0; t < nt; t += 2) {
            const bool last = (t == nt - 2);
            const char* a1 = cA + (size_t)(t + 1) * kstep;
            const char* a2 = last ? nA : cA + (size_t)(t + 2) * kstep; const char* b2 = last ? nB : cB + (size_t)(t + 2) * kstep;
            const char* a3 = a2 + kstep; const char* b3 = b2 + kstep;
            if (last && has_next) S.a_ready(nxt);
            if constexpr (SP2) {
            PG8_LDB(B0, 0, 0); PG8_LDB(B1, 0, 1); PG8_SCHED; PG8_LDA(At, 0, 0); PG8_STAGE(PG8_SA(1, 1), a1 + hstepA, voffA);
            PG8_WAIT_V(8); PG8_WAIT_L(0); PG8_BAR; PG8_MMA(0, 0, At, B0); PG8_MMA(0, 1, At, B1); PG8_BAR; PG8_SCHED;
            PG8_LDA(At, 0, 1); PG8_STAGE(PG8_SB(0, 0), b2, voffB); PG8_STAGE(PG8_SB(0, 1), b2 + hstepB, voffB); PG8_STAGE(PG8_SA(0, 0), a2, voffA);
            PG8_WAIT_V(8); PG8_WAIT_L(0); PG8_BAR; PG8_MMA(1, 0, At, B0); PG8_MMA(1, 1, At, B1); PG8_BAR; PG8_SCHED;
            PG8_LDB(B0, 1, 0); PG8_LDB(B1, 1, 1); PG8_SCHED; PG8_LDA(At, 1, 0); PG8_STAGE(PG8_SA(0, 1), a2 + hstepA, voffA);
            PG8_WAIT_V(8); PG8_WAIT_L(0); PG8_BAR; PG8_MMA(0, 0, At, B0); PG8_MMA(0, 1, At, B1); PG8_BAR; PG8_SCHED;
            PG8_LDA(At, 1, 1); PG8_STAGE(PG8_SB(1, 0), b3, voffB); PG8_STAGE(PG8_SB(1, 1), b3 + hstepB, voffB); PG8_STAGE(PG8_SA(1, 0), a3, voffA);
            PG8_WAIT_V(8); PG8_WAIT_L(0); PG8_BAR; PG8_MMA(1, 0, At, B0); PG8_MMA(1, 1, At, B1); PG8_BAR; PG8_SCHED;
            } else {
            PG8_LDB(B0, 0, 0); PG8_SCHED; PG8_LDA(At, 0, 0); PG8_STAGE(PG8_SA(1, 1), a1 + hstepA, voffA);
            PG8_WAIT_L(8); PG8_BAR; PG8_WAIT_L(0); PG8_MMA(0, 0, At, B0); PG8_BAR; PG8_SCHED;
            PG8_LDB(B1, 0, 1); PG8_STAGE(PG8_SB(0, 0), b2, voffB);
            PG8_BAR; PG8_WAIT_L(0); PG8_MMA(0, 1, At, B1); PG8_BAR;
            PG8_LDA(At, 0, 1); PG8_STAGE(PG8_SA(0, 0), a2, voffA);
            PG8_BAR; PG8_WAIT_L(0); PG8_MMA(1, 0, At, B0); PG8_BAR; PG8_SCHED;
            PG8_STAGE(PG8_SB(0, 1), b2 + hstepB, voffB);
            PG8_WAIT_V(6); PG8_BAR; PG8_MMA(1, 1, At, B1); PG8_BAR;
            PG8_LDB(B0, 1, 0); PG8_SCHED; PG8_LDA(At, 1, 0); PG8_STAGE(PG8_SA(0, 1), a2 + hstepA, voffA);
            PG8_WAIT_L(8); PG8_BAR; PG8_WAIT_L(0); PG8_MMA(0, 0, At, B0); PG8_BAR; PG8_SCHED;
            PG8_LDB(B1, 1, 1); PG8_STAGE(PG8_SB(1, 0), b3, voffB);
            PG8_BAR; PG8_WAIT_L(0); PG8_MMA(0, 1, At, B1); PG8_BAR;
            PG8_LDA(At, 1, 1); PG8_STAGE(PG8_SA(1, 0), a3, voffA);
            PG8_BAR; PG8_WAIT_L(0); PG8_MMA(1, 0, At, B0); PG8_BAR; PG8_SCHED;
            PG8_STAGE(PG8_SB(1, 1), b3 + hstepB, voffB);
            PG8_WAIT_V(6); PG8_BAR; PG8_MMA(1, 1, At, B1); PG8_BAR;
            }
        }
        if constexpr (ALIGN_EPI) { if (wr == 0) PG8_BAR; }
        if constexpr (!Epi::AFTER_DRAIN) { E(acc, cur, wr, wc, fr, fq); S.done(cur); }
        if (!has_next) break;
#pragma unroll
        for (int a = 0; a < 2; ++a)
#pragma unroll
            for (int b = 0; b < 2; ++b)
#pragma unroll
                for (int m = 0; m < 4; ++m)
#pragma unroll
                    for (int n = 0; n < 2; ++n) acc[a][b][m][n] = (f32x4){0.f, 0.f, 0.f, 0.f};
        cur = nxt; cA = nA; cB = nB; ++ui;
        if constexpr (ALIGN_EPI) { if (wr == 1) PG8_BAR; }
    }
    PG8_WAIT_V(0);
    if constexpr (!ALIGN_EPI) { if (wr == 0) PG8_BAR; }
    PG8_BAR;
    if constexpr (Epi::AFTER_DRAIN) { E.fused(acc, cur, wr, wc, fr, fq, lds, wid, lane); S.done(cur); }
#undef PG8_SA
#undef PG8_SB
#undef PG8_STAGE
#undef PG8_LDA
#undef PG8_LDB
#undef PG8_MMA
#undef PG8_WAIT_V
#undef PG8_WAIT_L
#undef PG8_BAR
#undef PG8_SCHED
}
}

namespace att {
using bf16x8 = __attribute__((ext_vector_type(8))) short;
using s16x4  = __attribute__((ext_vector_type(4))) short;
using f32x16 = __attribute__((ext_vector_type(16))) float;
using u32x4  = __attribute__((ext_vector_type(4))) unsigned;
constexpr int NW = 8, QBLK = 32, KVBLK = 64, DV = 128;
constexpr float THRN = 8.f;
constexpr size_t SHM_V = KVBLK * DV * 2, SHM_KMAX = KVBLK * 128 * 2, SHM_ATTN = 2 * SHM_V + 2 * SHM_KMAX + NW * 64 * 4;
#define SBAR() __builtin_amdgcn_sched_barrier(0)
template <int DQK> __device__ __forceinline__ int kswz(int row, int colB) { if constexpr (DQK == 128) return row * 256 + (colB ^ ((row & 15) << 4)); else return row * 128 + (colB ^ (((row >> 1) & 7) << 4)); }
__device__ __forceinline__ int crow(int r, int hi) { return (r & 3) + 8 * (r >> 2) + 4 * hi; }
typedef float f32x2_t __attribute__((ext_vector_type(2))); typedef __bf16 bf16x2_t __attribute__((ext_vector_type(2)));
__device__ __forceinline__ unsigned cvtpk(float lo, float hi) { const f32x2_t v = {lo, hi}; const bf16x2_t b = __builtin_convertvector(v, bf16x2_t); return __builtin_bit_cast(unsigned, b); }

template <int DQK> __device__ __forceinline__ void partialSM(f32x16& p0, f32x16& p1, float& m_reg, float& mn, float& alpha) {
  constexpr float SCALE = DQK == 128 ? 0.088388347648318440f : 0.125f;
  constexpr float C = SCALE * 1.4426950408889634f;
  float pmax = p0[0];
#pragma unroll
  for (int r = 1; r < 16; ++r) pmax = fmaxf(pmax, p0[r]);
#pragma unroll
  for (int r = 0; r < 16; ++r) pmax = fmaxf(pmax, p1[r]);
  { auto rr = __builtin_amdgcn_permlane32_swap(__float_as_uint(pmax), __float_as_uint(pmax), false, false);
    pmax = fmaxf(__uint_as_float(rr[0]), __uint_as_float(rr[1])); }
  if (__builtin_expect(__all(pmax - m_reg <= THRN / SCALE), 1)) { mn = m_reg; alpha = 1.f; }
  else { mn = fmaxf(m_reg, pmax); alpha = __builtin_amdgcn_exp2f((m_reg - mn) * C); m_reg = mn; }
  float mnC = -mn * C;
#pragma unroll
  for (int r = 0; r < 16; ++r) p0[r] = fmaf(p0[r], C, mnC);
#pragma unroll
  for (int r = 0; r < 16; ++r) p1[r] = fmaf(p1[r], C, mnC);
#pragma unroll
  for (int r = 0; r < 16; ++r) p0[r] = __builtin_amdgcn_exp2f(p0[r]);
}
__device__ __forceinline__ void finishSM(f32x16& p0, f32x16& p1, float alpha, float& l_reg, bf16x8& pa0, bf16x8& pa1, bf16x8& pa2, bf16x8& pa3) {
#pragma unroll
  for (int r = 0; r < 16; ++r) p1[r] = __builtin_amdgcn_exp2f(p1[r]);
  float ps = 0;
#pragma unroll
  for (int r = 0; r < 16; ++r) ps += p0[r];
#pragma unroll
  for (int r = 0; r < 16; ++r) ps += p1[r];
  { auto rr = __builtin_amdgcn_permlane32_swap(__float_as_uint(ps), __float_as_uint(ps), false, false);
    ps = __uint_as_float(rr[0]) + __uint_as_float(rr[1]); }
  l_reg = l_reg * alpha + ps;
#define PK4(P, BASE, OUT) do { unsigned a0 = cvtpk(P[BASE + 0], P[BASE + 1]), a1 = cvtpk(P[BASE + 2], P[BASE + 3]);   \
    unsigned b0 = cvtpk(P[BASE + 4], P[BASE + 5]), b1 = cvtpk(P[BASE + 6], P[BASE + 7]);                              \
    auto r0 = __builtin_amdgcn_permlane32_swap(a0, b0, false, false); auto r1 = __builtin_amdgcn_permlane32_swap(a1, b1, false, false); \
    u32x4 w = {r0[0], r1[0], r0[1], r1[1]}; OUT = *reinterpret_cast<bf16x8*>(&w); } while (0)
  PK4(p0, 0, pa0); PK4(p0, 8, pa1); PK4(p1, 0, pa2); PK4(p1, 8, pa3);
#undef PK4
}
template <int DQK> __device__ __forceinline__ void qkt(f32x16& p0, f32x16& p1, const char* Ks, const bf16x8* qr, int r32, int hi) {
  p0 = f32x16{}; p1 = f32x16{};
#pragma unroll
  for (int d0 = 0; d0 < DQK / 16; ++d0) { int cb = (d0 * 16 + hi * 8) * 2;
    bf16x8 b0 = *reinterpret_cast<const bf16x8*>(Ks + kswz<DQK>(r32, cb));
    bf16x8 b1 = *reinterpret_cast<const bf16x8*>(Ks + kswz<DQK>(32 + r32, cb));
    p0 = __builtin_amdgcn_mfma_f32_32x32x16_bf16(b0, qr[d0], p0, 0, 0, 0);
    p1 = __builtin_amdgcn_mfma_f32_32x32x16_bf16(b1, qr[d0], p1, 0, 0, 0); }
}
__device__ __forceinline__ int v_st(int k, int c) { const int kk = (k & ~0xC) | ((k & 4) << 1) | ((k & 8) >> 1); return ((kk >> 3) * 4 + (c >> 5)) * 512 + ((kk & 7) * 32 + (c & 31)) * 2; }
__device__ __forceinline__ int v_rd_base(int lane) { return ((lane & 3) << 3) | (((lane >> 2) & 3) << 6) | (((lane >> 4) & 1) << 5) | (((lane >> 5) & 1) << 8); }
constexpr int v_rd_off(int d0, int ks, int half) { return d0 * 512 + ks * 4096 + half * 2048; }
template <int OFF> __device__ __forceinline__ s16x4 tr_read(int vb) {
  s16x4 r; asm volatile("ds_read_b64_tr_b16 %0, %1 offset:%2" : "=&v"(r) : "v"(vb), "i"(OFF) : "memory"); return r;
}
template <int D0> __device__ __forceinline__ void pv_one(f32x16& od, int vb, bf16x8 pa0, bf16x8 pa1, bf16x8 pa2, bf16x8 pa3) {
  const s16x4 l0 = tr_read<v_rd_off(D0, 0, 0)>(vb), h0 = tr_read<v_rd_off(D0, 0, 1)>(vb), l1 = tr_read<v_rd_off(D0, 1, 0)>(vb), h1 = tr_read<v_rd_off(D0, 1, 1)>(vb);
  const s16x4 l2 = tr_read<v_rd_off(D0, 2, 0)>(vb), h2 = tr_read<v_rd_off(D0, 2, 1)>(vb), l3 = tr_read<v_rd_off(D0, 3, 0)>(vb), h3 = tr_read<v_rd_off(D0, 3, 1)>(vb);
  asm volatile("s_waitcnt lgkmcnt(0)" ::: "memory"); SBAR();
#define PK(L, H) (bf16x8){L[0], L[1], L[2], L[3], H[0], H[1], H[2], H[3]}
  od = __builtin_amdgcn_mfma_f32_32x32x16_bf16(pa0, PK(l0, h0), od, 0, 0, 0);
  od = __builtin_amdgcn_mfma_f32_32x32x16_bf16(pa1, PK(l1, h1), od, 0, 0, 0);
  od = __builtin_amdgcn_mfma_f32_32x32x16_bf16(pa2, PK(l2, h2), od, 0, 0, 0);
  od = __builtin_amdgcn_mfma_f32_32x32x16_bf16(pa3, PK(l3, h3), od, 0, 0, 0);
#undef PK
}
__device__ __forceinline__ void pv_d0(f32x16* o, int vb, bf16x8 pa0, bf16x8 pa1, bf16x8 pa2, bf16x8 pa3) {
  pv_one<0>(o[0], vb, pa0, pa1, pa2, pa3); pv_one<1>(o[1], vb, pa0, pa1, pa2, pa3); pv_one<2>(o[2], vb, pa0, pa1, pa2, pa3); pv_one<3>(o[3], vb, pa0, pa1, pa2, pa3);
}

struct EpiArgs { bf16_t* O; float* S0; const float* g; float lam; };

template <int DQK, int LDQ, int LDK, int LDV, int LDO, int MODE>
__device__ __forceinline__ void attn_dense_body(const bf16_t* __restrict__ Qb, const bf16_t* __restrict__ Kh, const bf16_t* __restrict__ Vh, const EpiArgs ea, int seq, char* lds) {
  constexpr size_t SHM_K = KVBLK * DQK * 2;
  int tid_ = threadIdx.x; asm volatile("" : "+v"(tid_));
  const int tid = tid_, wid = tid >> 6, lane = tid & 63, r32 = lane & 31, hi = lane >> 5;
  char* V_lds = lds; char* K_lds = lds + 2 * SHM_V;
  float* ws = (float*)(lds + 2 * SHM_V + 2 * SHM_KMAX) + wid * 64; float* li_l = ws; float* al_l = ws + 32;
  float m_reg = -1e30f, l_reg = 0; f32x16 o[4] = {}; bf16x8 qr[DQK / 16];
  const bf16_t* Qw = Qb + (long)(wid * QBLK + r32) * LDQ + hi * 8;
#pragma unroll
  for (int d0 = 0; d0 < DQK / 16; ++d0) qr[d0] = *reinterpret_cast<const bf16x8*>(Qw + d0 * 16);
  const int sr = tid >> 4, sc = (tid & 15) * 8, vst0 = v_st(sr, sc), vst1 = v_st(32 + sr, sc);
  const int kr64 = tid >> 3, kc64 = (tid & 7) * 8;
  const int vb0 = (int)(uintptr_t)V_lds + v_rd_base(lane);
  struct { bf16x8 vs0, vs1, ks0, ks1; } sr_[2];
#define SLOAD(i, k0) do { sr_[i].vs0 = *reinterpret_cast<const bf16x8*>(&Vh[(long)((k0) + sr) * LDV + sc]); sr_[i].vs1 = *reinterpret_cast<const bf16x8*>(&Vh[(long)((k0) + 32 + sr) * LDV + sc]); \
    if constexpr (DQK == 128) { sr_[i].ks0 = *reinterpret_cast<const bf16x8*>(&Kh[(long)((k0) + sr) * LDK + sc]); sr_[i].ks1 = *reinterpret_cast<const bf16x8*>(&Kh[(long)((k0) + 32 + sr) * LDK + sc]); } \
    else { sr_[i].ks0 = *reinterpret_cast<const bf16x8*>(&Kh[(long)((k0) + kr64) * LDK + kc64]); } } while (0)
#define SWRITE(b, i) do { *(bf16x8*)(V_lds + (b) * SHM_V + vst0) = sr_[i].vs0; *(bf16x8*)(V_lds + (b) * SHM_V + vst1) = sr_[i].vs1; \
    if constexpr (DQK == 128) { *(bf16x8*)(K_lds + (b) * SHM_K + kswz<128>(sr, sc * 2)) = sr_[i].ks0; *(bf16x8*)(K_lds + (b) * SHM_K + kswz<128>(32 + sr, sc * 2)) = sr_[i].ks1; } \
    else { *(bf16x8*)(K_lds + (b) * SHM_K + kswz<64>(kr64, kc64 * 2)) = sr_[i].ks0; } } while (0)
#define SWAIT() do { if constexpr (DQK == 128) asm volatile("s_waitcnt vmcnt(4)" ::: "memory"); else asm volatile("s_waitcnt vmcnt(3)" ::: "memory"); } while (0)
#define RESC(a) do { if (__any((a) < 1.f)) { if (hi == 0) al_l[r32] = (a); asm volatile("s_waitcnt lgkmcnt(0)" ::: "memory"); \
    _Pragma("unroll") for (int d = 0; d < 4; ++d) _Pragma("unroll") for (int r = 0; r < 16; ++r) o[d][r] *= al_l[crow(r, hi)]; } } while (0)
  f32x16 pA0, pA1, pB0, pB1; float mnA, mnB, alA, alB; bf16x8 pa0, pa1, pa2, pa3; const int NT = seq / KVBLK;
  constexpr int SE = 0, SO = 1;
  SLOAD(SE, 0); asm volatile("s_waitcnt vmcnt(0)" ::: "memory"); SWRITE(0, SE); __syncthreads();
  qkt<DQK>(pA0, pA1, K_lds, qr, r32, hi); partialSM<DQK>(pA0, pA1, m_reg, mnA, alA);
  SLOAD(SO, KVBLK); if (2 < NT) SLOAD(SE, 2 * KVBLK);
  SWAIT(); SWRITE(1, SO); __syncthreads();
  for (int j = 1; j + 1 < NT; j += 2) {
    SBAR(); qkt<DQK>(pB0, pB1, K_lds + SHM_K, qr, r32, hi);
    finishSM(pA0, pA1, alA, l_reg, pa0, pa1, pa2, pa3); SBAR();
    SLOAD(SO, (j + 2) * KVBLK); SBAR();
    pv_d0(o, vb0, pa0, pa1, pa2, pa3); partialSM<DQK>(pB0, pB1, m_reg, mnB, alB);
    __syncthreads(); SWAIT(); SWRITE(0, SE);
    RESC(alB); __syncthreads();
    SBAR(); qkt<DQK>(pA0, pA1, K_lds, qr, r32, hi);
    finishSM(pB0, pB1, alB, l_reg, pa0, pa1, pa2, pa3); SBAR();
    if (j + 3 < NT) SLOAD(SE, (j + 3) * KVBLK); SBAR();
    pv_d0(o, vb0 + (int)SHM_V, pa0, pa1, pa2, pa3); partialSM<DQK>(pA0, pA1, m_reg, mnA, alA);
    __syncthreads(); SWAIT(); SWRITE(1, SO);
    RESC(alA); __syncthreads();
  }
  SBAR(); qkt<DQK>(pB0, pB1, K_lds + SHM_K, qr, r32, hi);
  finishSM(pA0, pA1, alA, l_reg, pa0, pa1, pa2, pa3); SBAR();
  pv_d0(o, vb0, pa0, pa1, pa2, pa3); partialSM<DQK>(pB0, pB1, m_reg, mnB, alB);
  __syncthreads(); RESC(alB);
  finishSM(pB0, pB1, alB, l_reg, pa0, pa1, pa2, pa3); SBAR();
  pv_d0(o, vb0 + (int)SHM_V, pa0, pa1, pa2, pa3);
  if (hi == 0) li_l[r32] = l_reg; asm volatile("s_waitcnt lgkmcnt(0)" ::: "memory");
  float rli[16];
#pragma unroll
  for (int r = 0; r < 16; ++r) rli[r] = __builtin_amdgcn_rcpf(li_l[crow(r, hi)]);
  if constexpr (MODE == 0) {
    bf16_t* Ow = ea.O + (long)(wid * QBLK) * LDO;
#pragma unroll
    for (int r = 0; r < 16; ++r) { const int orow = crow(r, hi);
#pragma unroll
      for (int d0 = 0; d0 < 4; ++d0) Ow[(long)orow * LDO + d0 * 32 + r32] = (bf16_t)(cvtpk(o[d0][r] * rli[r], 0.f) & 0xffffu); }
  } else if constexpr (MODE == 1) {
    float* Sw = ea.S0 + (wid * QBLK) * 128;
#pragma unroll
    for (int r = 0; r < 16; ++r) { const int orow = crow(r, hi);
#pragma unroll
      for (int d0 = 0; d0 < 4; ++d0) Sw[orow * 128 + d0 * 32 + r32] = o[d0][r] * rli[r]; }
  } else {
    const volatile float* Sw = ea.S0 + (wid * QBLK) * 128;
    bf16_t* Ow = ea.O + (long)(wid * QBLK) * LDO;
    float gv[4];
#pragma unroll
    for (int d0 = 0; d0 < 4; ++d0) gv[d0] = ea.g[d0 * 32 + r32] * (1.0f - LAM_INIT);
#pragma unroll
    for (int r = 0; r < 16; ++r) { const int orow = crow(r, hi); float dv[4]; float ss = 0.f;
#pragma unroll
      for (int d0 = 0; d0 < 4; ++d0) { dv[d0] = Sw[orow * 128 + d0 * 32 + r32] - ea.lam * (o[d0][r] * rli[r]); ss += dv[d0] * dv[d0]; }
#pragma unroll
      for (int x = 1; x < 32; x <<= 1) ss += __shfl_xor(ss, x);
      const float rstd = 1.0f / sqrtf(ss * (1.0f / 128.0f) + EPS);
#pragma unroll
      for (int d0 = 0; d0 < 4; ++d0) Ow[(long)orow * LDO + d0 * 32 + r32] = (bf16_t)(cvtpk(dv[d0] * rstd * gv[d0], 0.f) & 0xffffu); }
  }
  __syncthreads();
#undef SLOAD
#undef SWRITE
#undef SWAIT
#undef RESC
}

typedef short v4i16_t __attribute__((ext_vector_type(4)));
#define PP_NEGM(dqk) (true)
#ifndef PP_GRP
#define PP_GRP(w) ((w) >> 2)
#endif
constexpr int PP_NS = 4;
constexpr int PP_VOFF = PP_NS * 16384, PP_WSOFF = 2 * PP_NS * 16384, PP_LDS = PP_WSOFF + NW * 256;
#ifndef PP_THRL
#define PP_THRL 11.5f
#endif
constexpr float THRL = PP_THRL;
__device__ __forceinline__ int swap23(int k) { return (k & ~0xC) | ((k & 4) << 1) | ((k & 8) >> 1); }
#define PP_WAITBAR() asm volatile("s_waitcnt vmcnt(0) lgkmcnt(0)\n\ts_barrier" ::: "memory")
#define PP_WAITBAR_N(N) asm volatile("s_waitcnt vmcnt(%0) lgkmcnt(0)\n\ts_barrier" :: "n"(N) : "memory")
#define PP_BAR() asm volatile("s_waitcnt lgkmcnt(0)\n\ts_barrier" ::: "memory")
template <int DQK, int WHAT  > struct PPA {
  static constexpr int NQ = WHAT == 2 ? 0 : DQK / 8, NF = NQ + (WHAT >= 1 ? 16 : 0), PD = DQK == 128 ? 4 : 8, HOFF = 32 * DQK * 2;
  static constexpr int ops(int i) { return i < NQ ? 1 : 2; }
  static constexpr int newer(int i) { int n = 0; for (int k = i + 1; k < NF && k <= i + PD; ++k) n += ops(k); return n > 15 ? 15 : n; }
  template <int I> static __device__ __forceinline__ void load(bf16x8 (&F)[NF], const int (&ka)[DQK / 16], int va) {
    if constexpr (I < NQ) { constexpr int d0 = I >> 1, h = I & 1;
      asm volatile("ds_read_b128 %0, %1 offset:%2" : "=&v"(F[I]) : "v"(ka[d0]), "n"(h * HOFF)); }
    else { constexpr int x = I - NQ, ks = x >> 2, d = x & 3; s16x4 lo, hi;
      asm volatile("ds_read_b64_tr_b16 %0, %1 offset:%2" : "=&v"(lo) : "v"(va), "n"(v_rd_off(d, ks, 0)));
      asm volatile("ds_read_b64_tr_b16 %0, %1 offset:%2" : "=&v"(hi) : "v"(va), "n"(v_rd_off(d, ks, 1)));
      F[I] = (bf16x8){lo[0], lo[1], lo[2], lo[3], hi[0], hi[1], hi[2], hi[3]}; }
  }
  template <int I> static __device__ __forceinline__ void pre(bf16x8 (&F)[NF], const int (&ka)[DQK / 16], int va) {
    if constexpr (I < PD && I < NF) { load<I>(F, ka, va); pre<I + 1>(F, ka, va); }
  }
  template <int I> static __device__ __forceinline__ void step(f32x16& S0, f32x16& S1, f32x16 (&o)[4], const bf16x8 (&qr)[DQK / 16], const bf16x8 (&pa)[4], bf16x8 (&F)[NF], const int (&ka)[DQK / 16], int va, const f32x16& negm) {
    if constexpr (I < NF) {
      if constexpr (I + PD < NF) load<I + PD>(F, ka, va);
      asm volatile("s_waitcnt lgkmcnt(%1)" : "+v"(F[I]) : "n"(newer(I)));
      if constexpr (I < NQ) { constexpr int d0 = I >> 1;
        if constexpr ((I & 1) == 0) { if constexpr (d0 == 0) S0 = __builtin_amdgcn_mfma_f32_32x32x16_bf16(F[I], qr[d0], PP_NEGM(DQK) ? negm : f32x16{}, 0, 0, 0); else S0 = __builtin_amdgcn_mfma_f32_32x32x16_bf16(F[I], qr[d0], S0, 0, 0, 0); }
        else                        { if constexpr (d0 == 0) S1 = __builtin_amdgcn_mfma_f32_32x32x16_bf16(F[I], qr[d0], PP_NEGM(DQK) ? negm : f32x16{}, 0, 0, 0); else S1 = __builtin_amdgcn_mfma_f32_32x32x16_bf16(F[I], qr[d0], S1, 0, 0, 0); }
      } else { constexpr int x = I - NQ, ks = x >> 2, d = x & 3; o[d] = __builtin_amdgcn_mfma_f32_32x32x16_bf16(pa[ks], F[I], o[d], 0, 0, 0); }
      __builtin_amdgcn_sched_barrier(0);
      step<I + 1>(S0, S1, o, qr, pa, F, ka, va, negm);
    }
  }
};
template <int DQK, int WHAT, int NFV>
__device__ __forceinline__ void pp_seg_pre(bf16x8 (&F)[NFV], const int (&ka)[DQK / 16], int va) {
  static_assert(NFV == PPA<DQK, WHAT>::NF, "fragment array size");
  __builtin_amdgcn_sched_barrier(0);
  PPA<DQK, WHAT>::template pre<0>(F, ka, va);
  __builtin_amdgcn_sched_barrier(0);
}
template <int DQK, int WHAT, int NFV>
__device__ __forceinline__ void pp_seg_run(f32x16& S0, f32x16& S1, f32x16 (&o)[4], const bf16x8 (&qr)[DQK / 16], const bf16x8 (&pa)[4], bf16x8 (&F)[NFV], const int (&ka)[DQK / 16], int va, f32x16& lsum, const f32x16& negm) {
  static_assert(NFV == PPA<DQK, WHAT>::NF, "fragment array size");
  using P = PPA<DQK, WHAT>;
  __builtin_amdgcn_sched_barrier(0);
  P::template step<0>(S0, S1, o, qr, pa, F, ka, va, negm);
  if constexpr (WHAT >= 1) {
    bf16x8 ones; { const u32x4 w = {0x3f803f80u, 0x3f803f80u, 0x3f803f80u, 0x3f803f80u}; ones = __builtin_bit_cast(bf16x8, w); }
#pragma unroll
    for (int ks = 0; ks < 4; ++ks) lsum = __builtin_amdgcn_mfma_f32_32x32x16_bf16(pa[ks], ones, lsum, 0, 0, 0);
  }
}
template <int DQK, int LDQ, int LDK, int LDV, int LDO, int MODE>
__device__ __forceinline__ void attn_pp_body(const bf16_t* __restrict__ Qb, const bf16_t* __restrict__ Kh, const bf16_t* __restrict__ Vh, const EpiArgs ea, int seq, LAS char* lds, int tstart) {
  constexpr int SHM_K = KVBLK * DQK * 2, SHM_VV = KVBLK * DV * 2, NKP = DQK == 128 ? 2 : 1;
  int tid_ = threadIdx.x; asm volatile("" : "+v"(tid_));
  const int tid = tid_, wid = __builtin_amdgcn_readfirstlane(tid >> 6), lane = tid & 63, r32 = lane & 31, hi = lane >> 5, grp = PP_GRP(wid);
  LAS float* al_l = (LAS float*)(lds + PP_WSOFF) + wid * 64; LAS float* li_l = al_l + 32;
  int koff[NKP], voff[2];
#pragma unroll
  for (int i = 0; i < NKP; ++i) { const int o = (wid + 8 * i) * 1024 + lane * 16;
    if constexpr (DQK == 128) { const int row = o >> 8, cb = (o & 255) ^ ((row & 15) << 4); koff[i] = row * LDK + (cb >> 1); }
    else { const int row = o >> 7, cb = (o & 127) ^ (((row >> 1) & 7) << 4); koff[i] = row * LDK + (cb >> 1); } }
#pragma unroll
  for (int i = 0; i < 2; ++i) { const int o = (wid + 8 * i) * 1024 + lane * 16, sub = o >> 9, within = (o & 511) >> 1;
    const int kk = (sub >> 2) * 8 + (within >> 5), c = (sub & 3) * 32 + (within & 31), s_ = swap23(kk), p_ = s_ & 15;
    const int key = (s_ & ~15) + (p_ & 3) + ((p_ >> 2) & 1) * 8 + ((p_ >> 3) & 1) * 4; voff[i] = key * LDV + c; }
#define DMA_K(t, slot) do { _Pragma("unroll") for (int i_ = 0; i_ < NKP; ++i_) __builtin_amdgcn_global_load_lds((const unsigned*)(Kh + (size_t)(t) * KVBLK * LDK + koff[i_]), \
    (LAS unsigned*)(lds + (slot) * SHM_K + (wid + 8 * i_) * 1024), 16, 0, 0); } while (0)
#define DMA_V(t, slot) do { _Pragma("unroll") for (int i_ = 0; i_ < 2; ++i_) __builtin_amdgcn_global_load_lds((const unsigned*)(Vh + (size_t)(t) * KVBLK * LDV + voff[i_]), \
    (LAS unsigned*)(lds + PP_VOFF + (slot) * SHM_VV + (wid + 8 * i_) * 1024), 16, 0, 0); } while (0)
  const int NT = seq / KVBLK, TM = NT - 1;
  DMA_K(tstart & TM, 0); DMA_V(tstart & TM, 0); DMA_K((tstart + 1) & TM, 1); DMA_V((tstart + 1) & TM, 1); DMA_K((tstart + 2) & TM, 2);
  bf16x8 qr[DQK / 16];
  { const bf16_t* Qw = Qb + (long)(wid * QBLK + r32) * LDQ + hi * 8;
#pragma unroll
    for (int d0 = 0; d0 < DQK / 16; ++d0) qr[d0] = *reinterpret_cast<const bf16x8*>(Qw + d0 * 16); }
  float m_ref = 0.f; f32x16 o[4] = {}; f32x16 lsum = {}; f32x16 negm = {}; f32x16 S0, S1; bf16x8 pa[4] = {};
  const int ldsb = (int)(unsigned)(size_t)lds;
  const int vrb = ldsb + PP_VOFF + v_rd_base(lane);
  int kz[DQK / 16];
#pragma unroll
  for (int d0 = 0; d0 < DQK / 16; ++d0) kz[d0] = ldsb + kswz<DQK>(r32, d0 * 32 + hi * 16);
  PP_WAITBAR();
  if (grp == 1) PP_BAR();
#define PP_FADD(a, b) ((a) + (b))
#define PK8(P, BASE, OUT) do { const u32x4 w_ = {cvtpk(P[BASE + 0], P[BASE + 1]), cvtpk(P[BASE + 2], P[BASE + 3]), cvtpk(P[BASE + 4], P[BASE + 5]), cvtpk(P[BASE + 6], P[BASE + 7])}; OUT = __builtin_bit_cast(bf16x8, w_); } while (0)
#if defined(PROBE_B)
#define PROBE_B_CODE { float d_ = m_ref; _Pragma("unroll") for (int q_ = 0; q_ < 64; ++q_) d_ = __builtin_fmaf(d_, 1.0001f, 0.5f); asm volatile("" :: "v"(d_)); }
#else
#define PROBE_B_CODE
#endif
#define PP_SEG_B(j, FIRST, sm1, sp2) do { \
    if ((j) + 3 < NT) DMA_K((tstart + (j) + 3) & TM, sm1); \
    if ((j) + 2 < NT) DMA_V((tstart + (j) + 2) & TM, sp2); \
    float a = fmaxf(fmaxf(S0[0], S0[1]), S1[0]), b = fmaxf(fmaxf(S0[2], S0[3]), S1[1]); a = fmaxf(fmaxf(a, S1[2]), S1[3]); \
    _Pragma("unroll") for (int r = 4; r < 16; r += 4) { a = fmaxf(fmaxf(a, S0[r]), S0[r + 1]); b = fmaxf(fmaxf(b, S0[r + 2]), S0[r + 3]); a = fmaxf(fmaxf(a, S1[r]), S1[r + 1]); b = fmaxf(fmaxf(b, S1[r + 2]), S1[r + 3]); } \
    float rm = fmaxf(a, b); \
    { auto rr = __builtin_amdgcn_permlane32_swap(__float_as_uint(rm), __float_as_uint(rm), false, false); rm = fmaxf(__uint_as_float(rr[0]), __uint_as_float(rr[1])); } \
    if (!PP_NEGM(DQK)) rm -= m_ref;                                  \
    if (FIRST) { m_ref += rm; if (PP_NEGM(DQK)) { _Pragma("unroll") for (int r = 0; r < 16; ++r) { S0[r] -= rm; S1[r] -= rm; negm[r] = -m_ref; } } }     \
    else if (__any(rm > THRL)) {                                     \
      const float dl = fmaxf(rm, 0.f); m_ref += dl; \
      if (PP_NEGM(DQK)) { _Pragma("unroll") for (int r = 0; r < 16; ++r) { S0[r] -= dl; S1[r] -= dl; negm[r] = -m_ref; } } \
      const float al = __builtin_amdgcn_exp2f(-dl); \
      if (hi == 0) al_l[r32] = al; asm volatile("s_waitcnt lgkmcnt(0)" ::: "memory"); \
      _Pragma("unroll") for (int r = 0; r < 16; ++r) { const float f_ = al_l[crow(r, hi)]; lsum[r] *= f_; _Pragma("unroll") for (int d = 0; d < 4; ++d) o[d][r] *= f_; } } \
    _Pragma("unroll") for (int r = 0; r < 16; ++r) { S0[r] = __builtin_amdgcn_exp2f(PP_NEGM(DQK) ? S0[r] : S0[r] - m_ref); S1[r] = __builtin_amdgcn_exp2f(PP_NEGM(DQK) ? S1[r] : S1[r] - m_ref); } \
    PK8(S0, 0, pa[0]); PK8(S0, 8, pa[1]); PK8(S1, 0, pa[2]); PK8(S1, 8, pa[3]); \
    PROBE_B_CODE \
  } while (0)
  { bf16x8 F0[PPA<DQK, 0>::NF]; pp_seg_pre<DQK, 0>(F0, kz, vrb); pp_seg_run<DQK, 0>(S0, S1, o, qr, pa, F0, kz, vrb, lsum, negm); }
  PP_WAITBAR();
  bf16x8 F[PPA<DQK, 1>::NF];
  PP_SEG_B(0, true, PP_NS - 1, 2);
#pragma unroll
  for (int z = 0; z < DQK / 16; ++z) kz[z] += SHM_K;
  pp_seg_pre<DQK, 1>(F, kz, vrb);
  PP_BAR();
  int sj = 1;
  for (int j = 1; j < NT; ++j) {
    const int sm1 = (sj + PP_NS - 1) & (PP_NS - 1), sp1 = (sj + 1) & (PP_NS - 1), sp2 = (sj + 2) & (PP_NS - 1);
    pp_seg_run<DQK, 1>(S0, S1, o, qr, pa, F, kz, vrb + sm1 * SHM_VV, lsum, negm);
    PP_WAITBAR();
    PP_SEG_B(j, false, sm1, sp2);
#pragma unroll
    for (int z = 0; z < DQK / 16; ++z) kz[z] += (sp1 == 0) ? -(PP_NS - 1) * SHM_K : SHM_K;
    if (j + 1 < NT) pp_seg_pre<DQK, 1>(F, kz, vrb);
    PP_BAR();
    sj = sp1;
  }
#undef PP_SEG_B
#undef PK8
#undef PP_FADD
  { bf16x8 F2[PPA<DQK, 2>::NF]; const int vd = vrb + ((sj + PP_NS - 1) & (PP_NS - 1)) * SHM_VV; pp_seg_pre<DQK, 2>(F2, kz, vd); pp_seg_run<DQK, 2>(S0, S1, o, qr, pa, F2, kz, vd, lsum, negm); }
  asm volatile("" ::: "memory");
  if (grp == 0) PP_BAR();
  float rli[16];
#pragma unroll
  for (int r = 0; r < 16; ++r) rli[r] = __builtin_amdgcn_rcpf(lsum[r]);
  if constexpr (MODE == 0) {
    bf16_t* Ow = ea.O + (long)(wid * QBLK) * LDO;
#pragma unroll
    for (int r = 0; r < 16; ++r) { const int orow = crow(r, hi);
#pragma unroll
      for (int d0 = 0; d0 < 4; ++d0) Ow[(long)orow * LDO + d0 * 32 + r32] = (bf16_t)(cvtpk(o[d0][r] * rli[r], 0.f) & 0xffffu); }
  } else if constexpr (MODE == 1) {
    float* Sw = ea.S0 + (wid * QBLK) * 128;
#pragma unroll
    for (int r = 0; r < 16; ++r) { const int orow = crow(r, hi);
#pragma unroll
      for (int d0 = 0; d0 < 4; ++d0) Sw[orow * 128 + d0 * 32 + r32] = o[d0][r] * rli[r]; }
  } else {
    const volatile float* Sw = ea.S0 + (wid * QBLK) * 128;
    bf16_t* Ow = ea.O + (long)(wid * QBLK) * LDO;
    float gv[4];
#pragma unroll
    for (int d0 = 0; d0 < 4; ++d0) gv[d0] = ea.g[d0 * 32 + r32] * (1.0f - LAM_INIT);
#pragma unroll
    for (int r = 0; r < 16; ++r) { const int orow = crow(r, hi); float dv[4]; float ss = 0.f;
#pragma unroll
      for (int d0 = 0; d0 < 4; ++d0) { dv[d0] = Sw[orow * 128 + d0 * 32 + r32] - ea.lam * (o[d0][r] * rli[r]); ss += dv[d0] * dv[d0]; }
#pragma unroll
      for (int x = 1; x < 32; x <<= 1) ss += __shfl_xor(ss, x);
      const float rstd = 1.0f / sqrtf(ss * (1.0f / 128.0f) + EPS);
#pragma unroll
      for (int d0 = 0; d0 < 4; ++d0) Ow[(long)orow * LDO + d0 * 32 + r32] = (bf16_t)(cvtpk(dv[d0] * rstd * gv[d0], 0.f) & 0xffffu); }
  }
  PP_WAITBAR();
#undef DMA_K
#undef DMA_V
}
#undef SBAR
}

#define XB_TMO      128
#define XB_XCNT(j)  (256  + 64 * (j))
#define XB_XSUB(j)  (1280 + 64 * (j))
#define XB_XGEN(j)  (2304 + 64 * (j))
#define XB_TOP      3328
#define XB_TOPGEN   3392
#define XCD_BAR_WORDS 3456
#define XB_SPIN_CAP (1u << 18)

__device__ __forceinline__ unsigned xb_ld(unsigned* p)              { return __hip_atomic_load(p, __ATOMIC_RELAXED, __HIP_MEMORY_SCOPE_AGENT); }
__device__ __forceinline__ unsigned xb_add(unsigned* p, unsigned v) { return __hip_atomic_fetch_add(p, v, __ATOMIC_RELAXED, __HIP_MEMORY_SCOPE_AGENT); }
__device__ __forceinline__ unsigned xb_xcc_id() { return (unsigned)__builtin_amdgcn_s_getreg((3 << 11) | 20) & 0xFu; }
#define XB_SPIN(cond, bar) do { unsigned _sp = 0; while (cond) { __builtin_amdgcn_s_sleep(1); \
    if ((++_sp & 255u) == 0u) { if (xb_ld(&(bar)[XB_TMO])) break; if (_sp > XB_SPIN_CAP) { atomicAdd(&(bar)[XB_TMO], 1u); break; } } } } while (0)

struct XcdBarrier {
    unsigned* bar; unsigned x;
    volatile LAS unsigned* st;
};

__device__ __forceinline__ XcdBarrier xcd_barrier_post(unsigned* bar, volatile LAS unsigned* st) {
    XcdBarrier b; b.bar = bar; b.x = xb_xcc_id(); b.st = st;
    if (threadIdx.x == 0) (void)xb_add(&bar[XB_XCNT(b.x)], 1u);
    return b;
}
__device__ __forceinline__ void xcd_barrier_complete(unsigned* bar, unsigned x, unsigned& nloc, unsigned& nx) {
    const unsigned G = gridDim.x * gridDim.y * gridDim.z;
    unsigned sum, cnt, mine, sp = 0u;
    for (;;) {
        sum = 0u; cnt = 0u; mine = 0u;
#pragma unroll
        for (unsigned j = 0; j < 16; ++j) { const unsigned c = xb_ld(&bar[XB_XCNT(j)]); sum += c; cnt += (c > 0u) ? 1u : 0u; mine = (j == x) ? c : mine; }
        if (sum == G) break;
        __builtin_amdgcn_s_sleep(1);
        if ((++sp & 255u) == 0u) { if (xb_ld(&bar[XB_TMO])) break; if (sp > XB_SPIN_CAP) { atomicAdd(&bar[XB_TMO], 1u); break; } }
    }
    nloc = mine > 0u ? mine : 1u; nx = cnt > 0u ? cnt : 1u;
}

__device__ __forceinline__ void xcd_barrier(const XcdBarrier& b) {
    asm volatile("s_waitcnt vmcnt(0)" ::: "memory");
    __syncthreads();
    if (threadIdx.x == 0) {
        unsigned* bar = b.bar;
        __builtin_amdgcn_s_waitcnt(0);
        unsigned nloc = b.st[0], nx = b.st[1];
        if (nloc == 0u) { xcd_barrier_complete(bar, b.x, nloc, nx); b.st[0] = nloc; b.st[1] = nx; }
        const unsigned old = xb_add(&bar[XB_XSUB(b.x)], 1u);
        const unsigned gen = old / nloc;
        if (old + 1u == (gen + 1u) * nloc) {
            __builtin_amdgcn_fence(__ATOMIC_RELEASE, "agent");
            asm volatile("s_waitcnt vmcnt(0)" ::: "memory");
            const unsigned og = xb_add(&bar[XB_TOP], 1u);
            const unsigned tg = og / nx;
            if (og + 1u == (tg + 1u) * nx) xb_add(&bar[XB_TOPGEN], 1u);
            else XB_SPIN(xb_ld(&bar[XB_TOPGEN]) == tg, bar);
            __builtin_amdgcn_fence(__ATOMIC_ACQUIRE, "agent");
            xb_add(&bar[XB_XGEN(b.x)], 1u);
            asm volatile("s_waitcnt vmcnt(0)" ::: "memory");
        } else {
            XB_SPIN(xb_ld(&bar[XB_XGEN(b.x)]) == gen, bar);
            __builtin_amdgcn_fence(__ATOMIC_ACQUIRE, "agent");
            asm volatile("s_waitcnt vmcnt(0)" ::: "memory");
        }
    }
    __syncthreads();
}

constexpr int LDS_BYTES = 131072 + 8192;
#ifndef EN_MASK
#define EN_MASK 0xFFFF
#endif
constexpr int ENM = EN_MASK;
constexpr int NPH = 46;
struct Ctx { LAS unsigned char* lds; char* ldsg; int tid, lane, wave, G, bid, gw, NGW; };

__host__ __device__ inline bool phase_active(int ph) {
    if (ph == 0 || ph == NPH - 1) return true;
    const int i = (ph - 1) / 11, s = (ph - 1) % 11, kind = i & 3;
    if (s < 4 || s > 7) return true;
    const int nm = (kind == 0) ? 2 : (kind == 2 ? 4 : 3);
    return (s - 4) < nm;
}

#ifndef PROBE_DUP
#define PROBE_DUP 0
#endif
__host__ __device__ inline bool probe_dup(int ph) {
    if (ph == 0) return PROBE_DUP == 6;
    if (ph == NPH - 1) return false;
    const int i = (ph - 1) / 11, s = (ph - 1) % 11, kind = i & 3;
    if (PROBE_DUP == 1) return s == 1 || s == 9;
    if (PROBE_DUP == 2) return s == 0 || s == 3 || s == 8;
    if (PROBE_DUP == 3) return kind == 1 && s == 5;
    if (PROBE_DUP == 4) return kind == 2 && s == 6;
    if (PROBE_DUP == 5) return s == 4 && kind != 0;
    if (PROBE_DUP == 7) return i == 0 && s == 2;
    return false;
}
__device__ __forceinline__ int dest_row(int mode, int n0) {
    if (mode == 0) return n0;
    if (mode == 1) { const int h = n0 >= DFF ? 1 : 0; const int j = n0 - h * DFF; return (j >> 7) * 256 + h * 128 + (j & 127); }
    if (n0 < 1024) return 2048 + n0;
    const int h = n0 >= 2048 ? 1 : 0; const int j = n0 - 1024 - h * 1024; return (j >> 7) * 256 + h * 128 + (j & 127);
}
__device__ __forceinline__ void transpose_item(const float* W, int K, int N, bf16_t* WT, int k0, int n0, int dn0, LAS float* scr, int lane) {
#pragma unroll 8
    for (int i = 0; i < 32; ++i) { const int kk = 2 * i + (lane >> 5); scr[kk * 33 + (lane & 31)] = W[(size_t)(k0 + kk) * N + n0 + (lane & 31)]; }
    LDS_WAIT(); asm volatile("" ::: "memory");
    const int c = lane & 7;
#pragma unroll
    for (int j = 0; j < 4; ++j) { const int n = (lane >> 3) + 8 * j; const LAS float* s = scr + (8 * c) * 33 + n;
        v4u o; o.x = cvt_pk_bf16(s[0 * 33], s[1 * 33]); o.y = cvt_pk_bf16(s[2 * 33], s[3 * 33]); o.z = cvt_pk_bf16(s[4 * 33], s[5 * 33]); o.w = cvt_pk_bf16(s[6 * 33], s[7 * 33]);
        *(v4u*)(WT + (size_t)(dn0 + n) * K + k0 + 8 * c) = o; }
    LDS_WAIT(); asm volatile("" ::: "memory");
}
template <class AP> __device__ __forceinline__ void prologue(const Ctx& F, AP a) {
    unsigned char* ws = a->ws;
    {
        LAS float* cact = (LAS float*)F.lds; LAS float* red = cact + 2048;
        const float* c = a->in[1];
        for (int u = F.tid; u < 2048; u += NTHR) cact[u] = silu_f(c[u]);
        __syncthreads();
        float* MODV = (float*)(ws + WS_MODV);
        for (int item = F.bid; item < 144; item += F.G) {
            const int i = item / 36, cb = item % 36;
            const float* W = a->in[2] + (size_t)i * 1024 * 9216 + cb * 256 + 4 * F.lane;
            f32x4 a0 = {0.f, 0.f, 0.f, 0.f}, a1 = a0;
            const int kbeg = F.wave * 128;
#pragma unroll 8
            for (int k = kbeg; k < kbeg + 128; ++k) { const f32x4 w = *(const f32x4*)(W + (size_t)k * 9216); a0 += w * cact[k]; a1 += w * cact[1024 + k]; }
            *(LAS f32x4*)(red + (F.wave * 2 + 0) * 256 + 4 * F.lane) = a0;
            *(LAS f32x4*)(red + (F.wave * 2 + 1) * 256 + 4 * F.lane) = a1;
            __syncthreads();
            { const int b = F.tid >> 8, col = F.tid & 255; float s = a->in[3][i * 9216 + cb * 256 + col];
#pragma unroll
              for (int w = 0; w < 8; ++w) s += red[(w * 2 + b) * 256 + col];
              MODV[(size_t)(i * 2 + b) * 9216 + cb * 256 + col] = s; }
            __syncthreads();
        }
        __syncthreads();
    }
    if (F.bid == 0) { unsigned* bw = (unsigned*)(ws + WS_BAR); int t0 = threadIdx.x; asm volatile("" : "+v"(t0)); for (int u = t0; u < XCD_BAR_WORDS; u += NTHR) bw[u] = 0u; }
    {
        float* R1 = (float*)(ws + WS_ROPE1); float* AX = (float*)(ws + WS_AXR);
        const int gt = F.gw * 64 + F.lane, NT = F.NGW * 64;
        for (int idx = gt; idx < SEQ * 8; idx += NT) { const int t = idx >> 3, j = idx & 7; float c, s; sincos_acc((float)t * INV1[j], c, s); R1[t * 16 + j] = c; R1[t * 16 + 8 + j] = s; }
        for (int idx = gt; idx < 256 * 32; idx += NT) { const int p = idx >> 5, f = idx & 31; float c, s; sincos_acc((float)p * INV2[f], c, s); AX[p * 64 + f] = c; AX[p * 64 + 32 + f] = s; }
    }
    {
        LAS float* scr = (LAS float*)(F.lds + F.wave * 16384);
        int base = 0;
        for (int mat = 0; mat < 26; ++mat) {
            const float* src; bf16_t* dst; int K, N, mode = 0;
            if (mat < 8)       { src = a->in[5] + (size_t)mat * D * 2 * DFF; dst = (bf16_t*)(ws + WS_WGU + (size_t)mat * SZ_WGU1); K = D; N = 2 * DFF; mode = 1; }
            else if (mat < 16) { src = a->in[6] + (size_t)(mat - 8) * DFF * D; dst = (bf16_t*)(ws + WS_WDN + (size_t)(mat - 8) * SZ_WDN1); K = DFF; N = D; }
            else if (mat < 20) { src = a->in[7] + (size_t)(mat - 16) * 65536; dst = (bf16_t*)(ws + WS_WPOOL) + (size_t)(mat - 16) * 65536; K = 256; N = 256; }
            else if (mat == 20) { src = a->in[9];  dst = (bf16_t*)(ws + WS_WDQKV); K = D; N = 3072; }
            else if (mat == 21) { src = a->in[12]; dst = (bf16_t*)(ws + WS_WDO);   K = D; N = D; }
            else if (mat == 22) { src = a->in[13]; dst = (bf16_t*)(ws + WS_WGQKV); K = D; N = 1536; }
            else if (mat == 23) { src = a->in[16]; dst = (bf16_t*)(ws + WS_WGO);   K = D; N = D; }
            else if (mat == 24) { src = a->in[17]; dst = (bf16_t*)(ws + WS_WCIN);  K = D; N = 3072; mode = 2; }
            else                { src = a->in[19]; dst = (bf16_t*)(ws + WS_WCOUT); K = D; N = D; }
            const int nblk = N / 32, nitems = (K / 64) * nblk;
            int first = (F.gw - base) % F.NGW; if (first < 0) first += F.NGW;
            for (int it = first; it < nitems; it += F.NGW) { const int kb = it / nblk, nb = it % nblk; transpose_item(src, K, N, dst, kb * 64, nb * 32, dest_row(mode, nb * 32), scr, F.lane); }
            base = (base + nitems) % F.NGW;
        }
    }
}

template <bool FINAL, bool XF32>
__device__ __forceinline__ void norm_phase(const Ctx& F, const void* xv, bf16_t* xn, float* xo, const float* g, const float* sh, const float* sc) {
    for (int b = 0; b < BATCH; ++b) {
        f32x4 A[4], Bv[4];
#pragma unroll
        for (int j = 0; j < 4; ++j) { const int col = 4 * F.lane + 256 * j; A[j] = *(const f32x4*)(g + col);
            if (!FINAL) { A[j] = A[j] * (*(const f32x4*)(sc + (size_t)b * 9216 + col) + 1.0f); Bv[j] = *(const f32x4*)(sh + (size_t)b * 9216 + col); } }
        for (int m0 = b * SEQ + F.gw; m0 < (b + 1) * SEQ; m0 += 2 * F.NGW) {
            f32x4 v[2][4]; float s[2] = {0.f, 0.f};
#pragma unroll
            for (int q = 0; q < 2; ++q) { const size_t m = (size_t)(m0 + q * F.NGW);
                if (XF32) { const f32x4* xr = (const f32x4*)((const float*)xv + m * D) + F.lane;
#pragma unroll
                    for (int j = 0; j < 4; ++j) v[q][j] = xr[64 * j];
                } else { const v2u* xr = (const v2u*)((const bf16_t*)xv + m * D) + F.lane;
#pragma unroll
                    for (int j = 0; j < 4; ++j) v[q][j] = half4_to_f32(xr[64 * j]); } }
#pragma unroll
            for (int q = 0; q < 2; ++q)
#pragma unroll
                for (int j = 0; j < 4; ++j) s[q] += (v[q][j].x * v[q][j].x + v[q][j].y * v[q][j].y) + (v[q][j].z * v[q][j].z + v[q][j].w * v[q][j].w);
#pragma unroll
            for (int q = 0; q < 2; ++q) { const size_t m = (size_t)(m0 + q * F.NGW);
                const float rstd = 1.0f / sqrtf(wave_sum(s[q]) * (1.0f / D) + EPS);
                if (FINAL) { f32x4* o = (f32x4*)(xo + m * D) + F.lane;
#pragma unroll
                    for (int j = 0; j < 4; ++j) o[64 * j] = v[q][j] * rstd * A[j];
                } else { v2u* o = (v2u*)(xn + m * D) + F.lane;
#pragma unroll
                    for (int j = 0; j < 4; ++j) { const f32x4 h = v[q][j] * rstd * A[j] + Bv[j]; v2u w; w.x = cvt_pk_bf16(h.x, h.y); w.y = cvt_pk_bf16(h.z, h.w); o[64 * j] = w; } } }
        }
    }
}
__device__ __forceinline__ void pooldiff_phase(const Ctx& F, const bf16_t* xn, bf16_t* pd) {
    const int gt = F.gw * 64 + F.lane, NT = F.NGW * 64;
    for (int task = gt; task < M * 128; task += NT) {
        const int m = task >> 7, c8 = task & 127, t = m & (SEQ - 1), b0 = m - t, hw = 1 << (c8 >> 5);
        const int lo = t - hw < 0 ? 0 : t - hw, hi = t + hw > SEQ ? SEQ : t + hw;
        float acc[8] = {0.f, 0.f, 0.f, 0.f, 0.f, 0.f, 0.f, 0.f}; v4u self = {0u, 0u, 0u, 0u};
        for (int r = lo; r < hi; ++r) { const v4u w = *(const v4u*)(xn + (size_t)(b0 + r) * D + c8 * 8); if (r == t) self = w;
            acc[0] += bf_lo(w.x); acc[1] += bf_hi(w.x); acc[2] += bf_lo(w.y); acc[3] += bf_hi(w.y); acc[4] += bf_lo(w.z); acc[5] += bf_hi(w.z); acc[6] += bf_lo(w.w); acc[7] += bf_hi(w.w); }
        const float inv = 1.0f / (float)(hi - lo);
        v4u o; o.x = cvt_pk_bf16(acc[0] * inv - bf_lo(self.x), acc[1] * inv - bf_hi(self.x)); o.y = cvt_pk_bf16(acc[2] * inv - bf_lo(self.y), acc[3] * inv - bf_hi(self.y));
        o.z = cvt_pk_bf16(acc[4] * inv - bf_lo(self.z), acc[5] * inv - bf_hi(self.z)); o.w = cvt_pk_bf16(acc[6] * inv - bf_lo(self.w), acc[7] * inv - bf_hi(self.w));
        *(v4u*)(pd + (size_t)m * D + c8 * 8) = o;
    }
}
__device__ __forceinline__ void conv_phase(const Ctx& F, const bf16_t* z, const bf16_t* gbuf, const float* wc, bf16_t* ca) {
    const int gt = F.gw * 64 + F.lane, NT = F.NGW * 64;
    for (int task = gt; task < M * 128; task += NT) {
        const int m = task >> 7, c8 = task & 127, t = m & (SEQ - 1);
        const v4u zero = {0u, 0u, 0u, 0u};
        const v4u zm = t > 0 ? *(const v4u*)(z + (size_t)(m - 1) * D + c8 * 8) : zero;
        const v4u z0 = *(const v4u*)(z + (size_t)m * D + c8 * 8);
        const v4u zp = t < SEQ - 1 ? *(const v4u*)(z + (size_t)(m + 1) * D + c8 * 8) : zero;
        const v4u gv = *(const v4u*)(gbuf + (size_t)m * D + c8 * 8);
        float w0[8], w1[8], w2[8];
#pragma unroll
        for (int e = 0; e < 8; ++e) { w0[e] = wc[c8 * 8 + e]; w1[e] = wc[D + c8 * 8 + e]; w2[e] = wc[2 * D + c8 * 8 + e]; }
        float r[8];
#define CV(e, f, comp) r[e] = f(gv.comp) * (w0[e] * f(zm.comp) + w1[e] * f(z0.comp) + w2[e] * f(zp.comp))
        CV(0, bf_lo, x); CV(1, bf_hi, x); CV(2, bf_lo, y); CV(3, bf_hi, y); CV(4, bf_lo, z); CV(5, bf_hi, z); CV(6, bf_lo, w); CV(7, bf_hi, w);
#undef CV
        v4u o; o.x = cvt_pk_bf16(r[0], r[1]); o.y = cvt_pk_bf16(r[2], r[3]); o.z = cvt_pk_bf16(r[4], r[5]); o.w = cvt_pk_bf16(r[6], r[7]);
        *(v4u*)(ca + (size_t)m * D + c8 * 8) = o;
    }
}
__device__ __forceinline__ void qknorm_phase(const Ctx& F, bf16_t* Q, bf16_t* K, const float* qg, const float* kg, const float* ax) {
    const int gt = F.gw * 64 + F.lane, NT = F.NGW * 64, sub = F.lane & 15;
    float gq[8], gk[8];
#pragma unroll
    for (int e = 0; e < 8; ++e) { gq[e] = qg[sub * 8 + e]; gk[e] = kg[sub * 8 + e]; }
    for (int task = gt >> 4; task < M * 10; task += NT >> 4) {
        const int m = task / 10, hh = task % 10, t = m & (SEQ - 1);
        bf16_t* p = hh < 8 ? Q + (size_t)m * 1024 + hh * 128 + sub * 8 : K + (size_t)m * 256 + (hh - 8) * 128 + sub * 8;
        const v4u w = *(const v4u*)p;
        float v[8] = {bf_lo(w.x), bf_hi(w.x), bf_lo(w.y), bf_hi(w.y), bf_lo(w.z), bf_hi(w.z), bf_lo(w.w), bf_hi(w.w)};
        float ss = 0.f;
#pragma unroll
        for (int e = 0; e < 8; ++e) ss += v[e] * v[e];
        ss += __shfl_xor(ss, 1); ss += __shfl_xor(ss, 2); ss += __shfl_xor(ss, 4); ss += __shfl_xor(ss, 8);
        const float rstd = 1.0f / sqrtf(ss * (1.0f / 128.0f) + EPS);
#pragma unroll
        for (int e = 0; e < 8; ++e) v[e] = v[e] * rstd * (hh < 8 ? gq[e] : gk[e]);
        const int pos = sub < 8 ? (t >> 6) : (t & 63);
        const float* cs = ax + pos * 64 + (sub & 3) * 8;
        const bool second = (sub & 4) != 0;
        const float qs = hh < 8 ? 0.12751743074602467f : 1.0f;
        float o[8];
#pragma unroll
        for (int e = 0; e < 8; ++e) { const float pv = __shfl_xor(v[e], 4); const float c = cs[e], s = cs[32 + e]; o[e] = (second ? (v[e] * c + pv * s) : (v[e] * c - pv * s)) * qs; }
        v4u ow; ow.x = cvt_pk_bf16(o[0], o[1]); ow.y = cvt_pk_bf16(o[2], o[3]); ow.z = cvt_pk_bf16(o[4], o[5]); ow.w = cvt_pk_bf16(o[6], o[7]);
        *(v4u*)p = ow;
    }
}

__global__ void __launch_bounds__(NTHR, 2) fwd_kernel(Args a) {
    extern __shared__ __attribute__((aligned(16))) unsigned char lds_raw[];
    const int ph_lo = a.ph_lo, ph_hi = a.ph_hi;
#define XB_ST() ((volatile LAS unsigned*)((LAS unsigned char*)lds_raw + LDS_BYTES - 64))
    if (threadIdx.x == 0) { XB_ST()[0] = 0u; XB_ST()[1] = 0u; }
    __syncthreads();
#define PHASE_SETUP() \
        KArgs ap = (KArgs)__builtin_amdgcn_kernarg_segment_ptr();     \
        asm volatile("" : "+s"(ap)); \
        unsigned char* ws = ap->ws; \
        float* MODV = (float*)(ws + WS_MODV); \
        bf16_t* XN = (bf16_t*)(ws + WS_XN); bf16_t* ACT = (bf16_t*)(ws + WS_ACT); \
        bf16_t* QB = (bf16_t*)(ws + WS_Q); bf16_t* KB = (bf16_t*)(ws + WS_K); bf16_t* VB = (bf16_t*)(ws + WS_V); bf16_t* AO = (bf16_t*)(ws + WS_AO); \
        float* X = ap->out; bf16_t* XB = (bf16_t*)(ws + WS_XB); \
        Ctx F;                                                      \
        F.lds = (LAS unsigned char*)lds_raw; F.ldsg = (char*)lds_raw; \
        { int t_ = threadIdx.x; asm volatile("" : "+v"(t_)); F.tid = t_; } \
        F.lane = F.tid & 63; F.wave = __builtin_amdgcn_readfirstlane(F.tid >> 6); \
        F.G = gridDim.x; F.bid = blockIdx.x; F.gw = F.bid * NWAVES + F.wave; F.NGW = F.G * NWAVES; \
        (void)MODV; (void)XN; (void)ACT; (void)QB; (void)KB; (void)VB; (void)AO; (void)X; (void)XB;
#define SEAM(PH, MORE) do { if (MORE) { \
            const bool one_launch_ = (ap->ph_lo == 0 && ap->ph_hi == NPH); \
            if (one_launch_ && (PH) > 0) { XcdBarrier xb; xb.bar = (unsigned*)(ap->ws + WS_BAR); xb.x = xb_xcc_id(); xb.st = XB_ST(); xcd_barrier(xb); } \
            else { cg::this_grid().sync(); \
                if (one_launch_) { unsigned* bw = (unsigned*)(ap->ws + WS_BAR); if (threadIdx.x == 0) (void)xb_add(&bw[XB_XCNT(xb_xcc_id())], 1u); } } } } while (0)
    int ph = ph_lo;
    if (ph == 0 && ph < ph_hi) { PHASE_SETUP(); if constexpr (ENM & 1) prologue(F, ap); SEAM(0, 1 < ph_hi); ph = 1; }
    int rep = 0; (void)rep;
    for (; ph < ph_hi; ++ph) {
        if (!phase_active(ph)) continue;
        PHASE_SETUP();
        if (false) {}
        else if (ph == NPH - 1) { if constexpr (ENM & 2) norm_phase<true, false>(F, XB, nullptr, X, ap->in[20], nullptr, nullptr); }
        else {
            const int i = (ph - 1) / 11, s = (ph - 1) % 11, kind = i & 3;
            const float* mv = MODV + (size_t)i * 2 * 9216;
            if (s == 0 || s == 3 || s == 8) { if constexpr (ENM & 2) {
                const int j = s == 0 ? 0 : (s == 3 ? 1 : 2);
                if (i == 0 && s == 0) norm_phase<false, true>(F, ap->in[0], XN, nullptr, ap->in[4] + (size_t)(i * 3 + j) * D, mv + (3 * j) * D, mv + (3 * j + 1) * D);
                else norm_phase<false, false>(F, XB, XN, nullptr, ap->in[4] + (size_t)(i * 3 + j) * D, mv + (3 * j) * D, mv + (3 * j + 1) * D); }
            } else if (s == 1 || s == 9) { if constexpr (ENM & 4) {
                const int f = s == 1 ? 0 : 1;
                pg8::Gemm g{XN, (const bf16_t*)(ws + WS_WGU + (size_t)(i * 2 + f) * SZ_WGU1), M, 2 * DFF, D, D, D, 0};
                pg8::StaticOrder S; S.init(M, 2 * DFF, F.G, F.bid);
                pg8::EpiSwiglu E{ACT, DFF};
                pg8::gemm_phase<pg8::EpiSwiglu, pg8::StaticOrder, true, true>(F.lds, g, S, E); }
            } else if (s == 2 || s == 10) { if constexpr (ENM & 8) {
                const int f = s == 2 ? 0 : 1;
                pg8::Gemm g{ACT, (const bf16_t*)(ws + WS_WDN + (size_t)(i * 2 + f) * SZ_WDN1), M, D, DFF, DFF, DFF, 0};
                pg8::StaticOrder S; S.init(M, D, F.G, F.bid);
                pg8::EpiRes E{(i == 0 && s == 2) ? (const void*)ap->in[0] : (const void*)XB, (i == 0 && s == 2) ? 1 : 0, XB, mv + (f == 0 ? 2 : 8) * D, nullptr, 0.5f};
                pg8::gemm_phase<pg8::EpiRes, pg8::StaticOrder, true, true>(F.lds, g, S, E); }
            } else if (kind == 0) { if constexpr (ENM & 16) {
                if (s == 4) pooldiff_phase(F, XN, AO);
                else { pg8::Gemm g{AO, (const bf16_t*)(ws + WS_WPOOL), M, D, 256, D, 256, 512};
                    pg8::StaticOrder S; S.init(M, D, F.G, F.bid);
                    pg8::EpiRes E{XB, 0, XB, mv + 5 * D, ap->in[8], 1.0f};
                    pg8::gemm_phase<pg8::EpiRes, pg8::StaticOrder, true, true>(F.lds, g, S, E); }
            } } else if (kind == 1) { if constexpr (ENM & 32) {
                if (s == 4) { pg8::Gemm g{XN, (const bf16_t*)(ws + WS_WDQKV), M, 3072, D, D, D, 0};
                    pg8::StaticOrder S; S.init(M, 3072, F.G, F.bid);
                    pg8::EpiDiffQkv E{ws, (const float*)(ws + WS_ROPE1)};
                    pg8::gemm_phase<pg8::EpiDiffQkv, pg8::StaticOrder, true, true>(F.lds, g, S, E);
                } else if (s == 5) {
                    const float* lm = ap->in[10]; float d01 = 0.f, d23 = 0.f;
                    for (int e = 0; e < 64; ++e) { d01 += lm[e] * lm[64 + e]; d23 += lm[128 + e] * lm[192 + e]; }
                    const float lam = expf(d01) - expf(d23) + LAM_INIT;
                    float* S0 = (float*)(ws + WS_S0) + (size_t)F.bid * 256 * 128;
                    for (int u = F.bid; u < BATCH * 8 * 64; u += F.G) {
                        const int it = u / F.G, xcd = F.bid & 7, idx = F.bid >> 3;
                        const int bh = (F.G == 256) ? it * 4 + (xcd >> 1) : (u >> 6), qb = (F.G == 256) ? (xcd & 1) * 32 + idx : (u & 63), b = bh >> 3, h = bh & 7;
                        const size_t qrow = (size_t)b * SEQ + (size_t)qb * 256, krow = (size_t)b * SEQ;
                        att::EpiArgs ea{AO + qrow * 1024 + h * 128, S0, ap->in[11], lam};
                        att::attn_pp_body<64, 1024, 1024, 1024, 1024, 1>(QB + qrow * 1024 + (2 * h) * 64, KB + krow * 1024 + (2 * h) * 64, VB + krow * 1024 + h * 128, ea, SEQ, (LAS char*)F.lds, (F.bid >> 3) * 2);
                        att::attn_pp_body<64, 1024, 1024, 1024, 1024, 2>(QB + qrow * 1024 + (2 * h + 1) * 64, KB + krow * 1024 + (2 * h + 1) * 64, VB + krow * 1024 + h * 128, ea, SEQ, (LAS char*)F.lds, (F.bid >> 3) * 2);
                    }
                } else { pg8::Gemm g{AO, (const bf16_t*)(ws + WS_WDO), M, D, D, D, D, 0};
                    pg8::StaticOrder S; S.init(M, D, F.G, F.bid);
                    pg8::EpiRes E{XB, 0, XB, mv + 5 * D, nullptr, 1.0f};
                    pg8::gemm_phase<pg8::EpiRes, pg8::StaticOrder, true, true>(F.lds, g, S, E); }
            } } else if (kind == 2) { if constexpr (ENM & 64) {
                if (s == 4) { pg8::Gemm g{XN, (const bf16_t*)(ws + WS_WGQKV), M, 1536, D, D, D, 0};
                    pg8::StaticOrder S; S.init(M, 1536, F.G, F.bid);
                    pg8::EpiGqaQkv E{ws};
                    pg8::gemm_phase<pg8::EpiGqaQkv, pg8::StaticOrder, true, true>(F.lds, g, S, E);
                } else if (s == 5) qknorm_phase(F, QB, KB, ap->in[14], ap->in[15], (const float*)(ws + WS_AXR));
                else if (s == 6) {
                    for (int u = F.bid; u < BATCH * 8 * 64; u += F.G) {
                        const int bh = u >> 6, qb = u & 63, b = bh >> 3, h = bh & 7, kvh = h >> 2;
                        const size_t qrow = (size_t)b * SEQ + (size_t)qb * 256, krow = (size_t)b * SEQ;
                        att::EpiArgs ea{AO + qrow * 1024 + h * 128, nullptr, nullptr, 0.f};
                        att::attn_pp_body<128, 1024, 256, 256, 1024, 0>(QB + qrow * 1024 + h * 128, KB + krow * 256 + kvh * 128, VB + krow * 256 + kvh * 128, ea, SEQ, (LAS char*)F.lds, (F.bid >> 3) * 2);
                    }
                } else { pg8::Gemm g{AO, (const bf16_t*)(ws + WS_WGO), M, D, D, D, D, 0};
                    pg8::StaticOrder S; S.init(M, D, F.G, F.bid);
                    pg8::EpiRes E{XB, 0, XB, mv + 5 * D, nullptr, 1.0f};
                    pg8::gemm_phase<pg8::EpiRes, pg8::StaticOrder, true, true>(F.lds, g, S, E); }
            } } else { if constexpr (ENM & 128) {
                if (s == 4) { pg8::Gemm g{XN, (const bf16_t*)(ws + WS_WCIN), M, 3072, D, D, D, 0};
                    pg8::StaticOrder S; S.init(M, 3072, F.G, F.bid);
                    pg8::EpiConvIn E{QB, KB};
                    pg8::gemm_phase<pg8::EpiConvIn, pg8::StaticOrder, true, true>(F.lds, g, S, E);
                } else if (s == 5) conv_phase(F, QB, KB, ap->in[18], AO);
                else { pg8::Gemm g{AO, (const bf16_t*)(ws + WS_WCOUT), M, D, D, D, D, 0};
                    pg8::StaticOrder S; S.init(M, D, F.G, F.bid);
                    pg8::EpiRes E{XB, 0, XB, mv + 5 * D, nullptr, 1.0f};
                    pg8::gemm_phase<pg8::EpiRes, pg8::StaticOrder, true, true>(F.lds, g, S, E); }
            } }
        }
        bool more = false;
        for (int q = ph + 1; q < ph_hi; ++q) if (phase_active(q)) { more = true; break; }
#if PROBE_DUP
        if (rep == 0 && probe_dup(ph)) { rep = 1; --ph; more = true; } else rep = 0;
#endif
        SEAM(ph, more);
#if PROBE_DUP == 8
        if (ph == 1) { for (int q = 0; q < 40; ++q) { XcdBarrier xb; xb.bar = (unsigned*)(ap->ws + WS_BAR); xb.x = xb_xcc_id(); xb.st = XB_ST(); xcd_barrier(xb); } }
#endif
    }
}

extern "C" void kernel_launch(void* const* d_in, const int* in_sizes, int n_in, void* d_out, int out_size, void* d_ws, size_t ws_size, hipStream_t stream) {
    static int grid = 0;
    if (grid == 0) {
        if (n_in != 21 || in_sizes[0] != M * D || out_size != M * D || ws_size < WS_END) {
            fprintf(stderr, "kernel_launch: shape mismatch n_in %d in0 %d out %d ws %zu (need %zu)\n", n_in, n_in > 0 ? in_sizes[0] : -1, out_size, ws_size, (size_t)WS_END); grid = -1; return; }
        int dev = 0, cus = 0, per_cu = 0;
        (void)hipGetDevice(&dev); (void)hipDeviceGetAttribute(&cus, hipDeviceAttributeMultiprocessorCount, dev);
        if (hipFuncSetAttribute((const void*)fwd_kernel, hipFuncAttributeMaxDynamicSharedMemorySize, LDS_BYTES) != hipSuccess) { fprintf(stderr, "kernel_launch: hipFuncSetAttribute failed\n"); grid = -1; return; }
        if (hipOccupancyMaxActiveBlocksPerMultiprocessor(&per_cu, (const void*)fwd_kernel, NTHR, LDS_BYTES) != hipSuccess || per_cu < 1) { fprintf(stderr, "kernel_launch: occupancy query gave %d\n", per_cu); per_cu = 1; }
        (void)hipGetLastError();
        grid = cus * per_cu;
        fprintf(stderr, "kernel_launch: grid %d (cus %d x %d)\n", grid, cus, per_cu);
    }
    if (grid < 0) return;
    Args a{};
    for (int i = 0; i < 21; ++i) a.in[i] = (const float*)d_in[i];
    a.out = (float*)d_out; a.ws = (unsigned char*)d_ws;
#if MK_ONE_LAUNCH
    a.ph_lo = 0; a.ph_hi = NPH;
    void* args[] = {&a};
    hipError_t e = hipLaunchCooperativeKernel((const void*)fwd_kernel, dim3(grid), dim3(NTHR), args, LDS_BYTES, stream);
    if (e != hipSuccess) fprintf(stderr, "cooperative launch failed: %s (grid %d)\n", hipGetErrorString(e), grid);
#else
    for (int ph = 0; ph < NPH; ++ph) {
        if (!phase_active(ph)) continue;
        a.ph_lo = ph; a.ph_hi = ph + 1;
        hipLaunchKernelGGL(fwd_kernel, dim3(grid), dim3(NTHR), LDS_BYTES, stream, a);
    }
#endif
}
```

```cpp
#include <hip/hip_runtime.h>
#include <hip/hip_bf16.h>
#include <hip/hip_cooperative_groups.h>
#include <cstdio>
#include <cstdint>
namespace cg = cooperative_groups;

#ifndef MK_ONE_LAUNCH
#define MK_ONE_LAUNCH 1
#endif

constexpr int D = 1024, BATCH = 2, SEQ = 16384, M = BATCH * SEQ, DEPTH = 4, DFF = 2816, NMOD = 9;
constexpr float EPS = 1e-6f;
constexpr float LAM_INIT = 0.35550906759096934f;
constexpr int NWAVES = 8, NTHR = 512;

__constant__ float INV1[8] = {1.000000000e+00f, 1.939227581e-01f, 3.760603070e-02f, 7.292665076e-03f, 1.414213446e-03f, 2.742481884e-04f, 5.318296462e-05f, 1.031338525e-05f};
__constant__ float INV2[32] = {1.000000000e+00f, 7.498942018e-01f, 5.623413324e-01f, 4.216965139e-01f, 3.162277639e-01f, 2.371373922e-01f, 1.778279394e-01f, 1.333521456e-01f, 1.000000015e-01f, 7.498941571e-02f, 5.623412877e-02f, 4.216964915e-02f, 3.162277862e-02f, 2.371373586e-02f, 1.778279431e-02f, 1.333521493e-02f, 9.999999776e-03f, 7.498942316e-03f, 5.623413250e-03f, 4.216964822e-03f, 3.162277862e-03f, 2.371373819e-03f, 1.778279431e-03f, 1.333521446e-03f, 1.000000047e-03f, 7.498941850e-04f, 5.623413017e-04f, 4.216965463e-04f, 3.162277862e-04f, 2.371373848e-04f, 1.778279402e-04f, 1.333521504e-04f};

constexpr size_t MiB = 1u << 20;
constexpr size_t WS_MODV  = 0;
constexpr size_t WS_ROPE1 = 1 * MiB;
constexpr size_t WS_AXR   = 2 * MiB;
constexpr size_t WS_AXC   = 2 * MiB + 65536;
constexpr size_t WS_BAR   = 3 * MiB;
constexpr size_t WS_WGU   = 4 * MiB;
constexpr size_t SZ_WGU1  = (size_t)2 * DFF * D * 2;
constexpr size_t WS_WDN   = WS_WGU + 8 * SZ_WGU1;
constexpr size_t SZ_WDN1  = (size_t)D * DFF * 2;
constexpr size_t WS_WPOOL = WS_WDN + 8 * SZ_WDN1;
constexpr size_t WS_WDQKV = WS_WPOOL + (size_t)1024 * 256 * 2;
constexpr size_t WS_WDO   = WS_WDQKV + (size_t)3072 * 1024 * 2;
constexpr size_t WS_WGQKV = WS_WDO + (size_t)1024 * 1024 * 2;
constexpr size_t WS_WGO   = WS_WGQKV + (size_t)1536 * 1024 * 2;
constexpr size_t WS_WCIN  = WS_WGO + (size_t)1024 * 1024 * 2;
constexpr size_t WS_WCOUT = WS_WCIN + (size_t)3072 * 1024 * 2;
constexpr size_t WS_XN    = ((WS_WCOUT + (size_t)1024 * 1024 * 2 + MiB - 1) / MiB) * MiB;
constexpr size_t SZ_ACT1K = (size_t)M * D * 2;
constexpr size_t WS_ACT   = WS_XN + SZ_ACT1K;
constexpr size_t WS_Q     = WS_ACT, WS_K = WS_ACT + SZ_ACT1K;
constexpr size_t WS_V     = WS_ACT + (size_t)M * DFF * 2;
constexpr size_t WS_AO    = WS_V + SZ_ACT1K;
constexpr size_t WS_S0    = WS_AO + SZ_ACT1K;
constexpr size_t WS_XB    = WS_S0 + (size_t)256 * 256 * 128 * 4;
constexpr size_t WS_END   = WS_XB + SZ_ACT1K;

struct Args { const float* in[21]; float* out; unsigned char* ws; int ph_lo, ph_hi; };
typedef const __attribute__((address_space(4))) Args* KArgs;

#define LAS __attribute__((address_space(3)))
typedef unsigned short bf16_t;
typedef unsigned v4u __attribute__((ext_vector_type(4)));
typedef unsigned v2u __attribute__((ext_vector_type(2)));
typedef float f32x4 __attribute__((ext_vector_type(4)));
typedef float f32x2 __attribute__((ext_vector_type(2)));
#define LDS_WAIT() asm volatile("s_waitcnt lgkmcnt(0)" ::: "memory")
__device__ __forceinline__ unsigned cvt_pk_bf16(float lo, float hi) { unsigned r; asm volatile("v_cvt_pk_bf16_f32 %0, %1, %2" : "=v"(r) : "v"(lo), "v"(hi)); return r; }
typedef _Float16 h16x4 __attribute__((ext_vector_type(4)));
typedef _Float16 h16x8 __attribute__((ext_vector_type(8)));
typedef float f32x8 __attribute__((ext_vector_type(8)));
__device__ __forceinline__ f32x4 half4_to_f32(v2u w) { return __builtin_convertvector(__builtin_bit_cast(h16x4, w), f32x4); }
__device__ __forceinline__ v2u f32_to_half4(f32x4 v) { return __builtin_bit_cast(v2u, __builtin_convertvector(v, h16x4)); }
__device__ __forceinline__ float bf_lo(unsigned w) { return __uint_as_float(w << 16); }
__device__ __forceinline__ float bf_hi(unsigned w) { return __uint_as_float(w & 0xffff0000u); }
__device__ __forceinline__ float wave_sum(float v) {
#pragma unroll
    for (int o = 1; o < 64; o <<= 1) v += __shfl_xor(v, o);
    return v;
}
__device__ __forceinline__ float silu_f(float g) { return g * __builtin_amdgcn_rcpf(1.0f + __builtin_amdgcn_exp2f(-1.4426950408889634f * g)); }
__device__ __forceinline__ void sincos_acc(float angf, float& c, float& s) {
    const double x = (double)angf;
    const double k = __builtin_rint(x * 0.63661977236758134308);
    double y = __builtin_fma(-k, 1.57079632679489655800, x); y = __builtin_fma(-k, 6.12323399573676603587e-17, y);
    const int q = (int)((long long)k & 3LL);
    const double y2 = y * y;
    const double sp = y * (1.0 + y2 * (-1.0 / 6 + y2 * (1.0 / 120 + y2 * (-1.0 / 5040 + y2 * (1.0 / 362880 + y2 * (-1.0 / 39916800 + y2 * (1.0 / 6227020800.0)))))));
    const double cp = 1.0 + y2 * (-0.5 + y2 * (1.0 / 24 + y2 * (-1.0 / 720 + y2 * (1.0 / 40320 + y2 * (-1.0 / 3628800 + y2 * (1.0 / 479001600.0 + y2 * (-1.0 / 87178291200.0)))))));
    const double ss = (q == 0) ? sp : (q == 1) ? cp : (q == 2) ? -sp : -cp;
    const double cc = (q == 0) ? cp : (q == 1) ? -sp : (q == 2) ? -cp : sp;
    c = (float)cc; s = (float)ss;
}


namespace pg8 {
#define PG8_LAS __attribute__((address_space(3)))
typedef unsigned short bf16_t;
typedef short bf16x8 __attribute__((ext_vector_type(8)));
typedef float f32x4 __attribute__((ext_vector_type(4)));
typedef unsigned u32x4 __attribute__((ext_vector_type(4)));
constexpr int BM = 256, BK = 64, HALF = 128, HTB = HALF * BK * 2  , STAGE_BYTES = 8 * HTB, NXCD = 8, WGM = 8;

__host__ __device__ __forceinline__ int lds_byte(int r, int c) { const int st = (r >> 4) * 2 + (c >> 5), rr = r & 15, cc = c & 31, ob = rr * 64 + cc * 2; return st * 1024 + (ob ^ (((ob >> 9) & 1) << 5)); }
__host__ __device__ __forceinline__ void stage_rc(int b, int& R, int& C) { const int st = b / 1024, sb = b % 1024, swz = sb ^ (((sb >> 9) & 1) << 5); R = (st >> 1) * 16 + swz / 64; C = (st & 1) * 32 + (swz % 64) / 2; }
__host__ __device__ __forceinline__ int perm32(int rho) { const int n = rho >> 4, i = rho & 15; return 8 * (i >> 2) + 4 * n + (i & 3); }

struct Unit { int pm, pn; };
struct Gemm { const bf16_t* A; const bf16_t* Bt; int M, N, K, lda, ldb, acolb; };

struct StaticOrder {
    int nM, nN, nwg, G, c;
    __host__ __device__ void init(int M, int N, int G_, int c_) { nM = M / BM; nN = N / BM; nwg = nM * nN; G = G_; c = c_; }
    __host__ __device__ bool next(int i, Unit& u) const {
        const long L = (long)i * G + c; if (L >= nwg) return false;
        int wgid = (int)L; { const int q = nwg / NXCD, r = nwg % NXCD, xcd = wgid % NXCD, off = wgid / NXCD; wgid = (xcd < r ? xcd * (q + 1) : r * (q + 1) + (xcd - r) * q) + off; }
        const int nig = WGM * nN, gid = wgid / nig, fm = gid * WGM, gsz = (nM - fm) < WGM ? (nM - fm) : WGM;
        u.pm = fm + ((wgid % nig) % gsz); u.pn = (wgid % nig) / gsz; return true;
    }
    __device__ __forceinline__ void a_ready(const Unit&) const {}
    __device__ __forceinline__ void done(const Unit&) const {}
};

__device__ __forceinline__ unsigned cvt_pk_bf16(float lo, float hi) { unsigned r; asm volatile("v_cvt_pk_bf16_f32 %0, %1, %2" : "=v"(r) : "v"(lo), "v"(hi)); return r; }
__device__ __forceinline__ float silu_f(float g) { return g * __builtin_amdgcn_rcpf(1.0f + __builtin_amdgcn_exp2f(-1.4426950408889634f * g)); }
__device__ __forceinline__ u32x4 pack8(const f32x4 v0, const f32x4 v1) { u32x4 w; w.x = cvt_pk_bf16(v0[0], v0[1]); w.y = cvt_pk_bf16(v0[2], v0[3]); w.z = cvt_pk_bf16(v1[0], v1[1]); w.w = cvt_pk_bf16(v1[2], v1[3]); return w; }

typedef _Float16 h16x8 __attribute__((ext_vector_type(8))); typedef float f32x8 __attribute__((ext_vector_type(8)));
__device__ __forceinline__ void unpack8(const u32x4 w, f32x4& a, f32x4& b) { const f32x8 f = __builtin_convertvector(__builtin_bit_cast(h16x8, w), f32x8);
    a = (f32x4){f[0], f[1], f[2], f[3]}; b = (f32x4){f[4], f[5], f[6], f[7]}; }
__device__ __forceinline__ u32x4 pack8h(const f32x4 a, const f32x4 b) { const f32x8 f = {a[0], a[1], a[2], a[3], b[0], b[1], b[2], b[3]}; return __builtin_bit_cast(u32x4, __builtin_convertvector(f, h16x8)); }
struct EpiRes {
    static constexpr bool PERM = true, AFTER_DRAIN = false;
    const void* xin; int xin_f32; bf16_t* xout; const float* gate; const float* cscale; float mul;
    __device__ __forceinline__ void operator()(const f32x4 (&acc)[2][2][4][2], const Unit& u, int wr, int wc, int fr, int fq) const {
        const int b = u.pm >> 6;
        const float* gb = gate + (size_t)b * 9216;
        const int col0 = u.pn * BM + wc * 32 + 8 * fq;
        f32x4 gv[2][2];
#pragma unroll
        for (int bj = 0; bj < 2; ++bj)
#pragma unroll
            for (int n = 0; n < 2; ++n) { f32x4 g = *(const f32x4*)(gb + col0 + bj * HALF + 4 * n) * mul;
                if (cscale) g = g * *(const f32x4*)(cscale + col0 + bj * HALF + 4 * n); gv[bj][n] = g; }
#pragma unroll
        for (int ai = 0; ai < 2; ++ai)
#pragma unroll
            for (int m = 0; m < 4; ++m) { const size_t off = (size_t)(u.pm * BM + ai * HALF + wr * 64 + m * 16 + fr) * 1024 + col0;
#pragma unroll
                for (int bj = 0; bj < 2; ++bj) { f32x4 x0, x1;
                    if (xin_f32) { const float* p = (const float*)xin + off + bj * HALF; x0 = *(const f32x4*)p; x1 = *(const f32x4*)(p + 4); }
                    else unpack8(*(const u32x4*)((const bf16_t*)xin + off + bj * HALF), x0, x1);
                    *(u32x4*)(xout + off + bj * HALF) = pack8h(x0 + gv[bj][0] * acc[ai][bj][m][0], x1 + gv[bj][1] * acc[ai][bj][m][1]); }
                if (m & 1) asm volatile("" ::: "memory"); }
    }
};
struct EpiSwiglu {
    static constexpr bool PERM = true, AFTER_DRAIN = false;
    bf16_t* O; int ldc;
    __device__ __forceinline__ void operator()(const f32x4 (&acc)[2][2][4][2], const Unit& u, int wr, int wc, int fr, int fq) const {
        const int col0 = u.pn * HALF + wc * 32 + 8 * fq;
#pragma unroll
        for (int ai = 0; ai < 2; ++ai)
#pragma unroll
            for (int m = 0; m < 4; ++m) { bf16_t* p = O + (size_t)(u.pm * BM + ai * HALF + wr * 64 + m * 16 + fr) * ldc + col0;
                f32x4 v0, v1;
#pragma unroll
                for (int e = 0; e < 4; ++e) { v0[e] = silu_f(acc[ai][0][m][0][e]) * acc[ai][1][m][0][e]; v1[e] = silu_f(acc[ai][0][m][1][e]) * acc[ai][1][m][1][e]; }
                *(u32x4*)p = pack8(v0, v1); }
    }
};
struct EpiConvIn {
    static constexpr bool PERM = true, AFTER_DRAIN = false;
    bf16_t* Z; bf16_t* GB;
    __device__ __forceinline__ void operator()(const f32x4 (&acc)[2][2][4][2], const Unit& u, int wr, int wc, int fr, int fq) const {
        if (u.pn < 8) {
            const int col0 = u.pn * HALF + wc * 32 + 8 * fq;
#pragma unroll
            for (int ai = 0; ai < 2; ++ai)
#pragma unroll
                for (int m = 0; m < 4; ++m) { bf16_t* p = Z + (size_t)(u.pm * BM + ai * HALF + wr * 64 + m * 16 + fr) * 1024 + col0;
                    *(u32x4*)p = pack8(acc[ai][0][m][0] * acc[ai][1][m][0], acc[ai][0][m][1] * acc[ai][1][m][1]); }
        } else {
            const int col0 = (u.pn - 8) * BM + wc * 32 + 8 * fq;
#pragma unroll
            for (int ai = 0; ai < 2; ++ai)
#pragma unroll
                for (int m = 0; m < 4; ++m) { bf16_t* p = GB + (size_t)(u.pm * BM + ai * HALF + wr * 64 + m * 16 + fr) * 1024 + col0;
#pragma unroll
                    for (int bj = 0; bj < 2; ++bj) *(u32x4*)(p + bj * HALF) = pack8(acc[ai][bj][m][0], acc[ai][bj][m][1]); }
        }
    }
};
struct EpiGqaQkv {
    static constexpr bool PERM = true, AFTER_DRAIN = false;
    unsigned char* ws;
    __device__ __forceinline__ void operator()(const f32x4 (&acc)[2][2][4][2], const Unit& u, int wr, int wc, int fr, int fq) const {
        const size_t boff = u.pn < 4 ? WS_Q : (u.pn == 4 ? WS_K : WS_V); bf16_t* base = (bf16_t*)(ws + boff); const int ld = u.pn < 4 ? 1024 : 256; const int colt = u.pn < 4 ? u.pn * BM : 0;
        const int col0 = colt + wc * 32 + 8 * fq;
#pragma unroll
        for (int ai = 0; ai < 2; ++ai)
#pragma unroll
            for (int m = 0; m < 4; ++m) { bf16_t* p = base + (size_t)(u.pm * BM + ai * HALF + wr * 64 + m * 16 + fr) * ld + col0;
#pragma unroll
                for (int bj = 0; bj < 2; ++bj) *(u32x4*)(p + bj * HALF) = pack8(acc[ai][bj][m][0], acc[ai][bj][m][1]); }
    }
};
struct EpiDiffQkv {
    static constexpr bool PERM = true, AFTER_DRAIN = false;
    unsigned char* ws; const float* rope;
    __device__ __forceinline__ void operator()(const f32x4 (&acc)[2][2][4][2], const Unit& u, int wr, int wc, int fr, int fq) const {
        const int t = u.pn >> 2; const size_t boff = t == 0 ? WS_Q : (t == 1 ? WS_K : WS_V); bf16_t* base = (bf16_t*)(ws + boff);
        const int col0 = (u.pn & 3) * BM + wc * 32 + 8 * fq;
        const bool rot = ((wc & 1) == 0) && (fq < 2);
#pragma unroll
        for (int ai = 0; ai < 2; ++ai)
#pragma unroll
            for (int m = 0; m < 4; ++m) { const int row = u.pm * BM + ai * HALF + wr * 64 + m * 16 + fr; bf16_t* p = base + (size_t)row * 1024 + col0;
                f32x4 cs0 = {1.f, 1.f, 1.f, 1.f}, cs1 = cs0, sn0 = {0.f, 0.f, 0.f, 0.f}, sn1 = sn0;
                if (t < 2 && rot) { const float* rp = rope + (size_t)(row & (SEQ - 1)) * 16; cs0 = *(const f32x4*)rp; cs1 = *(const f32x4*)(rp + 4); sn0 = *(const f32x4*)(rp + 8); sn1 = *(const f32x4*)(rp + 12);
                    if (fq == 0) { sn0 = -sn0; sn1 = -sn1; } }
#pragma unroll
                for (int bj = 0; bj < 2; ++bj) { f32x4 v0 = acc[ai][bj][m][0], v1 = acc[ai][bj][m][1];
                    if (t < 2) { f32x4 p0, p1;
#pragma unroll
                        for (int e = 0; e < 4; ++e) { p0[e] = __shfl_xor(v0[e], 16); p1[e] = __shfl_xor(v1[e], 16); }
                        v0 = v0 * cs0 + p0 * sn0; v1 = v1 * cs1 + p1 * sn1;
                        if (t == 0) { v0 = v0 * 0.18033688011112042f; v1 = v1 * 0.18033688011112042f; } }
                    *(u32x4*)(p + bj * HALF) = pack8(v0, v1); } }
    }
};

template <class Epi, class Sched, bool ALIGN_EPI = false, bool SP2 = false>
__device__ __forceinline__ void gemm_phase(PG8_LAS unsigned char* lds, const Gemm g, const Sched& S, const Epi& E) {
    int tid_ = threadIdx.x; asm volatile("" : "+v"(tid_)); const int tid = tid_, wid = __builtin_amdgcn_readfirstlane(tid >> 6), lane = tid & 63, wr = wid >> 2, wc = wid & 3, fr = lane & 15, fq = lane >> 4;
    const int K = g.K, nt = K / BK;
    unsigned voffA[2], voffB[2];
#pragma unroll
    for (int i = 0; i < 2; ++i) { int R, C; stage_rc(tid * 16 + i * 8192, R, C); const int Rb = Epi::PERM ? ((R & ~31) + perm32(R & 31)) : R;
        voffA[i] = (unsigned)(R * g.lda + C) * 2u; voffB[i] = (unsigned)(Rb * g.ldb + C) * 2u; }
    const size_t kstep = (size_t)(BK * 2);
    const size_t hstepA = (size_t)HALF * g.lda * 2, hstepB = (size_t)HALF * g.ldb * 2;
    const size_t tstepA = 2 * hstepA, tstepB = 2 * hstepB;
    const unsigned ldsw = (unsigned)wid * 1024u;
    const int aoff = lds_byte(wr * 64 + fr, fq * 8), boff = lds_byte(wc * 32 + fr, fq * 8);
#define PG8_SA(b, h) (((b) * 2 + (h)) * HTB)
#define PG8_SB(b, h) ((4 + (b) * 2 + (h)) * HTB)
#define PG8_STAGE(bufoff, gbase, voff) do { _Pragma("unroll") for (int _i = 0; _i < 2; ++_i) \
        __builtin_amdgcn_global_load_lds((const unsigned*)((const char*)(gbase) + (voff)[_i]), (PG8_LAS unsigned*)(lds + (bufoff) + ldsw + _i * 8192), 16, 0, 0); } while (0)
#define PG8_LDA(dst, b, h) do { _Pragma("unroll") for (int m = 0; m < 4; ++m) _Pragma("unroll") for (int k = 0; k < 2; ++k) dst[m][k] = *(const PG8_LAS bf16x8*)(lds + PG8_SA(b, h) + aoff + m * 2048 + k * 1024); } while (0)
#define PG8_LDB(dst, b, h) do { _Pragma("unroll") for (int n = 0; n < 2; ++n) _Pragma("unroll") for (int k = 0; k < 2; ++k) dst[n][k] = *(const PG8_LAS bf16x8*)(lds + PG8_SB(b, h) + boff + n * 2048 + k * 1024); } while (0)
#define PG8_MMA(ai, bj, At, Bt) do { __builtin_amdgcn_s_setprio(1); _Pragma("unroll") for (int m = 0; m < 4; ++m) _Pragma("unroll") for (int n = 0; n < 2; ++n) _Pragma("unroll") for (int k = 0; k < 2; ++k) \
        acc[ai][bj][m][n] = __builtin_amdgcn_mfma_f32_16x16x32_bf16(Bt[n][k], At[m][k], acc[ai][bj][m][n], 0, 0, 0); __builtin_amdgcn_s_setprio(0); } while (0)
#define PG8_WAIT_V(n) asm volatile("s_waitcnt vmcnt(" #n ")" ::: "memory")
#define PG8_WAIT_L(n) asm volatile("s_waitcnt lgkmcnt(" #n ")" ::: "memory")
#define PG8_BAR __builtin_amdgcn_s_barrier()
#define PG8_SCHED __builtin_amdgcn_sched_barrier(0)
    Unit cur, nxt; int ui = 0;
    if (!S.next(0, cur)) return;
    f32x4 acc[2][2][4][2];
#pragma unroll
    for (int a = 0; a < 2; ++a)
#pragma unroll
        for (int b = 0; b < 2; ++b)
#pragma unroll
            for (int m = 0; m < 4; ++m)
#pragma unroll
                for (int n = 0; n < 2; ++n) acc[a][b][m][n] = (f32x4){0.f, 0.f, 0.f, 0.f};
    bf16x8 At[4][2], B0[2][2], B1[2][2];
    const char* cA = (const char*)g.A + (size_t)cur.pm * tstepA + (size_t)cur.pn * g.acolb; const char* cB = (const char*)g.Bt + (size_t)cur.pn * tstepB;
    S.a_ready(cur);
    if constexpr (SP2) {
        PG8_STAGE(PG8_SB(0, 0), cB, voffB); PG8_STAGE(PG8_SB(0, 1), cB + hstepB, voffB); PG8_STAGE(PG8_SA(0, 0), cA, voffA); PG8_STAGE(PG8_SA(0, 1), cA + hstepA, voffA);
        if (wr == 1) PG8_BAR;
        PG8_WAIT_V(2); PG8_BAR;
        PG8_STAGE(PG8_SB(1, 0), cB + kstep, voffB); PG8_STAGE(PG8_SA(1, 0), cA + kstep, voffA); PG8_STAGE(PG8_SB(1, 1), cB + hstepB + kstep, voffB);
        PG8_WAIT_V(6); PG8_BAR;
    } else {
        PG8_STAGE(PG8_SB(0, 0), cB, voffB); PG8_STAGE(PG8_SA(0, 0), cA, voffA); PG8_STAGE(PG8_SB(0, 1), cB + hstepB, voffB); PG8_STAGE(PG8_SA(0, 1), cA + hstepA, voffA);
        if (wr == 1) PG8_BAR;
        PG8_WAIT_V(4); PG8_BAR;
        PG8_STAGE(PG8_SB(1, 0), cB + kstep, voffB); PG8_STAGE(PG8_SA(1, 0), cA + kstep, voffA); PG8_STAGE(PG8_SB(1, 1), cB + hstepB + kstep, voffB);
        PG8_WAIT_V(6); PG8_BAR;
    }
    for (;;) {
        const bool has_next = S.next(ui + 1, nxt);
        const char* nA = has_next ? (const char*)g.A + (size_t)nxt.pm * tstepA + (size_t)nxt.pn * g.acolb : cA; const char* nB = has_next ? (const char*)g.Bt + (size_t)nxt.pn * tstepB : cB;
        for (int t = 0; t < nt; t += 2) {
            const bool last = (t == nt - 2);
            const char* a1 = cA + (size_t)(t + 1) * kstep;
            const char* a2 = last ? nA : cA + (size_t)(t + 2) * kstep; const char* b2 = last ? nB : cB + (size_t)(t + 2) * kstep;
            const char* a3 = a2 + kstep; const char* b3 = b2 + kstep;
            if (last && has_next) S.a_ready(nxt);
            if constexpr (SP2) {
            PG8_LDB(B0, 0, 0); PG8_LDB(B1, 0, 1); PG8_SCHED; PG8_LDA(At, 0, 0); PG8_STAGE(PG8_SA(1, 1), a1 + hstepA, voffA);
            PG8_WAIT_V(8); PG8_WAIT_L(0); PG8_BAR; PG8_MMA(0, 0, At, B0); PG8_MMA(0, 1, At, B1); PG8_BAR; PG8_SCHED;
            PG8_LDA(At, 0, 1); PG8_STAGE(PG8_SB(0, 0), b2, voffB); PG8_STAGE(PG8_SB(0, 1), b2 + hstepB, voffB); PG8_STAGE(PG8_SA(0, 0), a2, voffA);
            PG8_WAIT_V(8); PG8_WAIT_L(0); PG8_BAR; PG8_MMA(1, 0, At, B0); PG8_MMA(1, 1, At, B1); PG8_BAR; PG8_SCHED;
            PG8_LDB(B0, 1, 0); PG8_LDB(B1, 1, 1); PG8_SCHED; PG8_LDA(At, 1, 0); PG8_STAGE(PG8_SA(0, 1), a2 + hstepA, voffA);
            PG8_WAIT_V(8); PG8_WAIT_L(0); PG8_BAR; PG8_MMA(0, 0, At, B0); PG8_MMA(0, 1, At, B1); PG8_BAR; PG8_SCHED;
            PG8_LDA(At, 1, 1); PG8_STAGE(PG8_SB(1, 0), b3, voffB); PG8_STAGE(PG8_SB(1, 1), b3 + hstepB, voffB); PG8_STAGE(PG8_SA(1, 0), a3, voffA);
            PG8_WAIT_V(8); PG8_WAIT_L(0); PG8_BAR; PG8_MMA(1, 0, At, B0); PG8_MMA(1, 1, At, B1); PG8_BAR; PG8_SCHED;
            } else {
            PG8_LDB(B0, 0, 0); PG8_SCHED; PG8_LDA(At, 0, 0); PG8_STAGE(PG8_SA(1, 1), a1 + hstepA, voffA);
            PG8_WAIT_L(8); PG8_BAR; PG8_WAIT_L(0); PG8_MMA(0, 0, At, B0); PG8_BAR; PG8_SCHED;
            PG8_LDB(B1, 0, 1); PG8_STAGE(PG8_SB(0, 0), b2, voffB);
            PG8_BAR; PG8_WAIT_L(0); PG8_MMA(0, 1, At, B1); PG8_BAR;
            PG8_LDA(At, 0, 1); PG8_STAGE(PG8_SA(0, 0), a2, voffA);
            PG8_BAR; PG8_WAIT_L(0); PG8_MMA(1, 0, At, B0); PG8_BAR; PG8_SCHED;
            PG8_STAGE(PG8_SB(0, 1), b2 + hstepB, voffB);
            PG8_WAIT_V(6); PG8_BAR; PG8_MMA(1, 1, At, B1); PG8_BAR;
            PG8_LDB(B0, 1, 0); PG8_SCHED; PG8_LDA(At, 1, 0); PG8_STAGE(PG8_SA(0, 1), a2 + hstepA, voffA);
            PG8_WAIT_L(8); PG8_BAR; PG8_WAIT_L(0); PG8_MMA(0, 0, At, B0); PG8_BAR; PG8_SCHED;
            PG8_LDB(B1, 1, 1); PG8_STAGE(PG8_SB(1, 0), b3, voffB);
            PG8_BAR; PG8_WAIT_L(0); PG8_MMA(0, 1, At, B1); PG8_BAR;
            PG8_LDA(At, 1, 1); PG8_STAGE(PG8_SA(1, 0), a3, voffA);
            PG8_BAR; PG8_WAIT_L(0); PG8_MMA(1, 0, At, B0); PG8_BAR; PG8_SCHED;
            PG8_STAGE(PG8_SB(1, 1), b3 + hstepB, voffB);
            PG8_WAIT_V(6); PG8_BAR; PG8_MMA(1, 1, At, B1); PG8_BAR;
            }
        }
        if constexpr (ALIGN_EPI) { if (wr == 0) PG8_BAR; }
        if constexpr (!Epi::AFTER_DRAIN) { E(acc, cur, wr, wc, fr, fq); S.done(cur); }
        if (!has_next) break;
#pragma unroll
        for (int a = 0; a < 2; ++a)
#pragma unroll
            for (int b = 0; b < 2; ++b)
#pragma unroll
                for (int m = 0; m < 4; ++m)
#pragma unroll
                    for (int n = 0; n < 2; ++n) acc[a][b][m][n] = (f32x4){0.f, 0.f, 0.f, 0.f};
        cur = nxt; cA = nA; cB = nB; ++ui;
        if constexpr (ALIGN_EPI) { if (wr == 1) PG8_BAR; }
    }
    PG8_WAIT_V(0);
    if constexpr (!ALIGN_EPI) { if (wr == 0) PG8_BAR; }
    PG8_BAR;
    if constexpr (Epi::AFTER_DRAIN) { E.fused(acc, cur, wr, wc, fr, fq, lds, wid, lane); S.done(cur); }
#undef PG8_SA
#undef PG8_SB
#undef PG8_STAGE
#undef PG8_LDA
#undef PG8_LDB
#undef PG8_MMA
#undef PG8_WAIT_V
#undef PG8_WAIT_L
#undef PG8_BAR
#undef PG8_SCHED
}
}

namespace att {
using bf16x8 = __attribute__((ext_vector_type(8))) short;
using s16x4  = __attribute__((ext_vector_type(4))) short;
using f32x16 = __attribute__((ext_vector_type(16))) float;
using u32x4  = __attribute__((ext_vector_type(4))) unsigned;
constexpr int NW = 8, QBLK = 32, KVBLK = 64, DV = 128;
constexpr float THRN = 8.f;
constexpr size_t SHM_V = KVBLK * DV * 2, SHM_KMAX = KVBLK * 128 * 2, SHM_ATTN = 2 * SHM_V + 2 * SHM_KMAX + NW * 64 * 4;
#define SBAR() __builtin_amdgcn_sched_barrier(0)
template <int DQK> __device__ __forceinline__ int kswz(int row, int colB) { if constexpr (DQK == 128) return row * 256 + (colB ^ ((row & 15) << 4)); else return row * 128 + (colB ^ (((row >> 1) & 7) << 4)); }
__device__ __forceinline__ int crow(int r, int hi) { return (r & 3) + 8 * (r >> 2) + 4 * hi; }
typedef float f32x2_t __attribute__((ext_vector_type(2))); typedef __bf16 bf16x2_t __attribute__((ext_vector_type(2)));
__device__ __forceinline__ unsigned cvtpk(float lo, float hi) { const f32x2_t v = {lo, hi}; const bf16x2_t b = __builtin_convertvector(v, bf16x2_t); return __builtin_bit_cast(unsigned, b); }

template <int DQK> __device__ __forceinline__ void partialSM(f32x16& p0, f32x16& p1, float& m_reg, float& mn, float& alpha) {
  constexpr float SCALE = DQK == 128 ? 0.088388347648318440f : 0.125f;
  constexpr float C = SCALE * 1.4426950408889634f;
  float pmax = p0[0];
#pragma unroll
  for (int r = 1; r < 16; ++r) pmax = fmaxf(pmax, p0[r]);
#pragma unroll
  for (int r = 0; r < 16; ++r) pmax = fmaxf(pmax, p1[r]);
  { auto rr = __builtin_amdgcn_permlane32_swap(__float_as_uint(pmax), __float_as_uint(pmax), false, false);
    pmax = fmaxf(__uint_as_float(rr[0]), __uint_as_float(rr[1])); }
  if (__builtin_expect(__all(pmax - m_reg <= THRN / SCALE), 1)) { mn = m_reg; alpha = 1.f; }
  else { mn = fmaxf(m_reg, pmax); alpha = __builtin_amdgcn_exp2f((m_reg - mn) * C); m_reg = mn; }
  float mnC = -mn * C;
#pragma unroll
  for (int r = 0; r < 16; ++r) p0[r] = fmaf(p0[r], C, mnC);
#pragma unroll
  for (int r = 0; r < 16; ++r) p1[r] = fmaf(p1[r], C, mnC);
#pragma unroll
  for (int r = 0; r < 16; ++r) p0[r] = __builtin_amdgcn_exp2f(p0[r]);
}
__device__ __forceinline__ void finishSM(f32x16& p0, f32x16& p1, float alpha, float& l_reg, bf16x8& pa0, bf16x8& pa1, bf16x8& pa2, bf16x8& pa3) {
#pragma unroll
  for (int r = 0; r < 16; ++r) p1[r] = __builtin_amdgcn_exp2f(p1[r]);
  float ps = 0;
#pragma unroll
  for (int r = 0; r < 16; ++r) ps += p0[r];
#pragma unroll
  for (int r = 0; r < 16; ++r) ps += p1[r];
  { auto rr = __builtin_amdgcn_permlane32_swap(__float_as_uint(ps), __float_as_uint(ps), false, false);
    ps = __uint_as_float(rr[0]) + __uint_as_float(rr[1]); }
  l_reg = l_reg * alpha + ps;
#define PK4(P, BASE, OUT) do { unsigned a0 = cvtpk(P[BASE + 0], P[BASE + 1]), a1 = cvtpk(P[BASE + 2], P[BASE + 3]);   \
    unsigned b0 = cvtpk(P[BASE + 4], P[BASE + 5]), b1 = cvtpk(P[BASE + 6], P[BASE + 7]);                              \
    auto r0 = __builtin_amdgcn_permlane32_swap(a0, b0, false, false); auto r1 = __builtin_amdgcn_permlane32_swap(a1, b1, false, false); \
    u32x4 w = {r0[0], r1[0], r0[1], r1[1]}; OUT = *reinterpret_cast<bf16x8*>(&w); } while (0)
  PK4(p0, 0, pa0); PK4(p0, 8, pa1); PK4(p1, 0, pa2); PK4(p1, 8, pa3);
#undef PK4
}
template <int DQK> __device__ __forceinline__ void qkt(f32x16& p0, f32x16& p1, const char* Ks, const bf16x8* qr, int r32, int hi) {
  p0 = f32x16{}; p1 = f32x16{};
#pragma unroll
  for (int d0 = 0; d0 < DQK / 16; ++d0) { int cb = (d0 * 16 + hi * 8) * 2;
    bf16x8 b0 = *reinterpret_cast<const bf16x8*>(Ks + kswz<DQK>(r32, cb));
    bf16x8 b1 = *reinterpret_cast<const bf16x8*>(Ks + kswz<DQK>(32 + r32, cb));
    p0 = __builtin_amdgcn_mfma_f32_32x32x16_bf16(b0, qr[d0], p0, 0, 0, 0);
    p1 = __builtin_amdgcn_mfma_f32_32x32x16_bf16(b1, qr[d0], p1, 0, 0, 0); }
}
__device__ __forceinline__ int v_st(int k, int c) { const int kk = (k & ~0xC) | ((k & 4) << 1) | ((k & 8) >> 1); return ((kk >> 3) * 4 + (c >> 5)) * 512 + ((kk & 7) * 32 + (c & 31)) * 2; }
__device__ __forceinline__ int v_rd_base(int lane) { return ((lane & 3) << 3) | (((lane >> 2) & 3) << 6) | (((lane >> 4) & 1) << 5) | (((lane >> 5) & 1) << 8); }
constexpr int v_rd_off(int d0, int ks, int half) { return d0 * 512 + ks * 4096 + half * 2048; }
template <int OFF> __device__ __forceinline__ s16x4 tr_read(int vb) {
  s16x4 r; asm volatile("ds_read_b64_tr_b16 %0, %1 offset:%2" : "=&v"(r) : "v"(vb), "i"(OFF) : "memory"); return r;
}
template <int D0> __device__ __forceinline__ void pv_one(f32x16& od, int vb, bf16x8 pa0, bf16x8 pa1, bf16x8 pa2, bf16x8 pa3) {
  const s16x4 l0 = tr_read<v_rd_off(D0, 0, 0)>(vb), h0 = tr_read<v_rd_off(D0, 0, 1)>(vb), l1 = tr_read<v_rd_off(D0, 1, 0)>(vb), h1 = tr_read<v_rd_off(D0, 1, 1)>(vb);
  const s16x4 l2 = tr_read<v_rd_off(D0, 2, 0)>(vb), h2 = tr_read<v_rd_off(D0, 2, 1)>(vb), l3 = tr_read<v_rd_off(D0, 3, 0)>(vb), h3 = tr_read<v_rd_off(D0, 3, 1)>(vb);
  asm volatile("s_waitcnt lgkmcnt(0)" ::: "memory"); SBAR();
#define PK(L, H) (bf16x8){L[0], L[1], L[2], L[3], H[0], H[1], H[2], H[3]}
  od = __builtin_amdgcn_mfma_f32_32x32x16_bf16(pa0, PK(l0, h0), od, 0, 0, 0);
  od = __builtin_amdgcn_mfma_f32_32x32x16_bf16(pa1, PK(l1, h1), od, 0, 0, 0);
  od = __builtin_amdgcn_mfma_f32_32x32x16_bf16(pa2, PK(l2, h2), od, 0, 0, 0);
  od = __builtin_amdgcn_mfma_f32_32x32x16_bf16(pa3, PK(l3, h3), od, 0, 0, 0);
#undef PK
}
__device__ __forceinline__ void pv_d0(f32x16* o, int vb, bf16x8 pa0, bf16x8 pa1, bf16x8 pa2, bf16x8 pa3) {
  pv_one<0>(o[0], vb, pa0, pa1, pa2, pa3); pv_one<1>(o[1], vb, pa0, pa1, pa2, pa3); pv_one<2>(o[2], vb, pa0, pa1, pa2, pa3); pv_one<3>(o[3], vb, pa0, pa1, pa2, pa3);
}

struct EpiArgs { bf16_t* O; float* S0; const float* g; float lam; };

template <int DQK, int LDQ, int LDK, int LDV, int LDO, int MODE>
__device__ __forceinline__ void attn_dense_body(const bf16_t* __restrict__ Qb, const bf16_t* __restrict__ Kh, const bf16_t* __restrict__ Vh, const EpiArgs ea, int seq, char* lds) {
  constexpr size_t SHM_K = KVBLK * DQK * 2;
  int tid_ = threadIdx.x; asm volatile("" : "+v"(tid_));
  const int tid = tid_, wid = tid >> 6, lane = tid & 63, r32 = lane & 31, hi = lane >> 5;
  char* V_lds = lds; char* K_lds = lds + 2 * SHM_V;
  float* ws = (float*)(lds + 2 * SHM_V + 2 * SHM_KMAX) + wid * 64; float* li_l = ws; float* al_l = ws + 32;
  float m_reg = -1e30f, l_reg = 0; f32x16 o[4] = {}; bf16x8 qr[DQK / 16];
  const bf16_t* Qw = Qb + (long)(wid * QBLK + r32) * LDQ + hi * 8;
#pragma unroll
  for (int d0 = 0; d0 < DQK / 16; ++d0) qr[d0] = *reinterpret_cast<const bf16x8*>(Qw + d0 * 16);
  const int sr = tid >> 4, sc = (tid & 15) * 8, vst0 = v_st(sr, sc), vst1 = v_st(32 + sr, sc);
  const int kr64 = tid >> 3, kc64 = (tid & 7) * 8;
  const int vb0 = (int)(uintptr_t)V_lds + v_rd_base(lane);
  struct { bf16x8 vs0, vs1, ks0, ks1; } sr_[2];
#define SLOAD(i, k0) do { sr_[i].vs0 = *reinterpret_cast<const bf16x8*>(&Vh[(long)((k0) + sr) * LDV + sc]); sr_[i].vs1 = *reinterpret_cast<const bf16x8*>(&Vh[(long)((k0) + 32 + sr) * LDV + sc]); \
    if constexpr (DQK == 128) { sr_[i].ks0 = *reinterpret_cast<const bf16x8*>(&Kh[(long)((k0) + sr) * LDK + sc]); sr_[i].ks1 = *reinterpret_cast<const bf16x8*>(&Kh[(long)((k0) + 32 + sr) * LDK + sc]); } \
    else { sr_[i].ks0 = *reinterpret_cast<const bf16x8*>(&Kh[(long)((k0) + kr64) * LDK + kc64]); } } while (0)
#define SWRITE(b, i) do { *(bf16x8*)(V_lds + (b) * SHM_V + vst0) = sr_[i].vs0; *(bf16x8*)(V_lds + (b) * SHM_V + vst1) = sr_[i].vs1; \
    if constexpr (DQK == 128) { *(bf16x8*)(K_lds + (b) * SHM_K + kswz<128>(sr, sc * 2)) = sr_[i].ks0; *(bf16x8*)(K_lds + (b) * SHM_K + kswz<128>(32 + sr, sc * 2)) = sr_[i].ks1; } \
    else { *(bf16x8*)(K_lds + (b) * SHM_K + kswz<64>(kr64, kc64 * 2)) = sr_[i].ks0; } } while (0)
#define SWAIT() do { if constexpr (DQK == 128) asm volatile("s_waitcnt vmcnt(4)" ::: "memory"); else asm volatile("s_waitcnt vmcnt(3)" ::: "memory"); } while (0)
#define RESC(a) do { if (__any((a) < 1.f)) { if (hi == 0) al_l[r32] = (a); asm volatile("s_waitcnt lgkmcnt(0)" ::: "memory"); \
    _Pragma("unroll") for (int d = 0; d < 4; ++d) _Pragma("unroll") for (int r = 0; r < 16; ++r) o[d][r] *= al_l[crow(r, hi)]; } } while (0)
  f32x16 pA0, pA1, pB0, pB1; float mnA, mnB, alA, alB; bf16x8 pa0, pa1, pa2, pa3; const int NT = seq / KVBLK;
  constexpr int SE = 0, SO = 1;
  SLOAD(SE, 0); asm volatile("s_waitcnt vmcnt(0)" ::: "memory"); SWRITE(0, SE); __syncthreads();
  qkt<DQK>(pA0, pA1, K_lds, qr, r32, hi); partialSM<DQK>(pA0, pA1, m_reg, mnA, alA);
  SLOAD(SO, KVBLK); if (2 < NT) SLOAD(SE, 2 * KVBLK);
  SWAIT(); SWRITE(1, SO); __syncthreads();
  for (int j = 1; j + 1 < NT; j += 2) {
    SBAR(); qkt<DQK>(pB0, pB1, K_lds + SHM_K, qr, r32, hi);
    finishSM(pA0, pA1, alA, l_reg, pa0, pa1, pa2, pa3); SBAR();
    SLOAD(SO, (j + 2) * KVBLK); SBAR();
    pv_d0(o, vb0, pa0, pa1, pa2, pa3); partialSM<DQK>(pB0, pB1, m_reg, mnB, alB);
    __syncthreads(); SWAIT(); SWRITE(0, SE);
    RESC(alB); __syncthreads();
    SBAR(); qkt<DQK>(pA0, pA1, K_lds, qr, r32, hi);
    finishSM(pB0, pB1, alB, l_reg, pa0, pa1, pa2, pa3); SBAR();
    if (j + 3 < NT) SLOAD(SE, (j + 3) * KVBLK); SBAR();
    pv_d0(o, vb0 + (int)SHM_V, pa0, pa1, pa2, pa3); partialSM<DQK>(pA0, pA1, m_reg, mnA, alA);
    __syncthreads(); SWAIT(); SWRITE(1, SO);
    RESC(alA); __syncthreads();
  }
  SBAR(); qkt<DQK>(pB0, pB1, K_lds + SHM_K, qr, r32, hi);
  finishSM(pA0, pA1, alA, l_reg, pa0, pa1, pa2, pa3); SBAR();
  pv_d0(o, vb0, pa0, pa1, pa2, pa3); partialSM<DQK>(pB0, pB1, m_reg, mnB, alB);
  __syncthreads(); RESC(alB);
  finishSM(pB0, pB1, alB, l_reg, pa0, pa1, pa2, pa3); SBAR();
  pv_d0(o, vb0 + (int)SHM_V, pa0, pa1, pa2, pa3);
  if (hi == 0) li_l[r32] = l_reg; asm volatile("s_waitcnt lgkmcnt(0)" ::: "memory");
  float rli[16];
#pragma unroll
  for (int r = 0; r < 16; ++r) rli[r] = __builtin_amdgcn_rcpf(li_l[crow(r, hi)]);
  if constexpr (MODE == 0) {
    bf16_t* Ow = ea.O + (long)(wid * QBLK) * LDO;
#pragma unroll
    for (int r = 0; r < 16; ++r) { const int orow = crow(r, hi);
#pragma unroll
      for (int d0 = 0; d0 < 4; ++d0) Ow[(long)orow * LDO + d0 * 32 + r32] = (bf16_t)(cvtpk(o[d0][r] * rli[r], 0.f) & 0xffffu); }
  } else if constexpr (MODE == 1) {
    float* Sw = ea.S0 + (wid * QBLK) * 128;
#pragma unroll
    for (int r = 0; r < 16; ++r) { const int orow = crow(r, hi);
#pragma unroll
      for (int d0 = 0; d0 < 4; ++d0) Sw[orow * 128 + d0 * 32 + r32] = o[d0][r] * rli[r]; }
  } else {
    const volatile float* Sw = ea.S0 + (wid * QBLK) * 128;
    bf16_t* Ow = ea.O + (long)(wid * QBLK) * LDO;
    float gv[4];
#pragma unroll
    for (int d0 = 0; d0 < 4; ++d0) gv[d0] = ea.g[d0 * 32 + r32] * (1.0f - LAM_INIT);
#pragma unroll
    for (int r = 0; r < 16; ++r) { const int orow = crow(r, hi); float dv[4]; float ss = 0.f;
#pragma unroll
      for (int d0 = 0; d0 < 4; ++d0) { dv[d0] = Sw[orow * 128 + d0 * 32 + r32] - ea.lam * (o[d0][r] * rli[r]); ss += dv[d0] * dv[d0]; }
#pragma unroll
      for (int x = 1; x < 32; x <<= 1) ss += __shfl_xor(ss, x);
      const float rstd = 1.0f / sqrtf(ss * (1.0f / 128.0f) + EPS);
#pragma unroll
      for (int d0 = 0; d0 < 4; ++d0) Ow[(long)orow * LDO + d0 * 32 + r32] = (bf16_t)(cvtpk(dv[d0] * rstd * gv[d0], 0.f) & 0xffffu); }
  }
  __syncthreads();
#undef SLOAD
#undef SWRITE
#undef SWAIT
#undef RESC
}

typedef short v4i16_t __attribute__((ext_vector_type(4)));
#define PP_NEGM(dqk) ((dqk) == 64)
#ifndef PP_GRP
#define PP_GRP(w) ((w) >> 2)
#endif
constexpr int PP_NS = 4;
constexpr int PP_VOFF = PP_NS * 16384, PP_WSOFF = 2 * PP_NS * 16384, PP_LDS = PP_WSOFF + NW * 256;
#ifndef PP_THRL
#define PP_THRL 11.5f
#endif
constexpr float THRL = PP_THRL;
__device__ __forceinline__ int swap23(int k) { return (k & ~0xC) | ((k & 4) << 1) | ((k & 8) >> 1); }
#define PP_WAITBAR() asm volatile("s_waitcnt vmcnt(0) lgkmcnt(0)\n\ts_barrier" ::: "memory")
#define PP_WAITBAR_N(N) asm volatile("s_waitcnt vmcnt(%0) lgkmcnt(0)\n\ts_barrier" :: "n"(N) : "memory")
#define PP_BAR() asm volatile("s_waitcnt lgkmcnt(0)\n\ts_barrier" ::: "memory")
template <int DQK, int WHAT  > struct PPA {
  static constexpr int NQ = WHAT == 2 ? 0 : DQK / 8, NF = NQ + (WHAT >= 1 ? 16 : 0), PD = DQK == 128 ? 6 : 8, HOFF = 32 * DQK * 2;
  static constexpr int ops(int i) { return i < NQ ? 1 : 2; }
  static constexpr int newer(int i) { int n = 0; for (int k = i + 1; k < NF && k <= i + PD; ++k) n += ops(k); return n > 15 ? 15 : n; }
  template <int I> static __device__ __forceinline__ void load(bf16x8 (&F)[NF], const int (&ka)[DQK / 16], int va) {
    if constexpr (I < NQ) { constexpr int d0 = I >> 1, h = I & 1;
      asm volatile("ds_read_b128 %0, %1 offset:%2" : "=&v"(F[I]) : "v"(ka[d0]), "n"(h * HOFF)); }
    else { constexpr int x = I - NQ, ks = x >> 2, d = x & 3; s16x4 lo, hi;
      asm volatile("ds_read_b64_tr_b16 %0, %1 offset:%2" : "=&v"(lo) : "v"(va), "n"(v_rd_off(d, ks, 0)));
      asm volatile("ds_read_b64_tr_b16 %0, %1 offset:%2" : "=&v"(hi) : "v"(va), "n"(v_rd_off(d, ks, 1)));
      F[I] = (bf16x8){lo[0], lo[1], lo[2], lo[3], hi[0], hi[1], hi[2], hi[3]}; }
  }
  template <int I> static __device__ __forceinline__ void pre(bf16x8 (&F)[NF], const int (&ka)[DQK / 16], int va) {
    if constexpr (I < PD && I < NF) { load<I>(F, ka, va); pre<I + 1>(F, ka, va); }
  }
  template <int I> static __device__ __forceinline__ void step(f32x16& S0, f32x16& S1, f32x16 (&o)[4], const bf16x8 (&qr)[DQK / 16], const bf16x8 (&pa)[4], bf16x8 (&F)[NF], const int (&ka)[DQK / 16], int va, const f32x16& negm) {
    if constexpr (I < NF) {
      if constexpr (I + PD < NF) load<I + PD>(F, ka, va);
      asm volatile("s_waitcnt lgkmcnt(%1)" : "+v"(F[I]) : "n"(newer(I)));
      if constexpr (I < NQ) { constexpr int d0 = I >> 1;
        if constexpr ((I & 1) == 0) { if constexpr (d0 == 0) S0 = __builtin_amdgcn_mfma_f32_32x32x16_bf16(F[I], qr[d0], PP_NEGM(DQK) ? negm : f32x16{}, 0, 0, 0); else S0 = __builtin_amdgcn_mfma_f32_32x32x16_bf16(F[I], qr[d0], S0, 0, 0, 0); }
        else                        { if constexpr (d0 == 0) S1 = __builtin_amdgcn_mfma_f32_32x32x16_bf16(F[I], qr[d0], PP_NEGM(DQK) ? negm : f32x16{}, 0, 0, 0); else S1 = __builtin_amdgcn_mfma_f32_32x32x16_bf16(F[I], qr[d0], S1, 0, 0, 0); }
      } else { constexpr int x = I - NQ, ks = x >> 2, d = x & 3; o[d] = __builtin_amdgcn_mfma_f32_32x32x16_bf16(pa[ks], F[I], o[d], 0, 0, 0); }
      __builtin_amdgcn_sched_barrier(0);
      step<I + 1>(S0, S1, o, qr, pa, F, ka, va, negm);
    }
  }
};
template <int DQK, int WHAT, int NFV>
__device__ __forceinline__ void pp_seg_pre(bf16x8 (&F)[NFV], const int (&ka)[DQK / 16], int va) {
  static_assert(NFV == PPA<DQK, WHAT>::NF, "fragment array size");
  __builtin_amdgcn_sched_barrier(0);
  PPA<DQK, WHAT>::template pre<0>(F, ka, va);
  __builtin_amdgcn_sched_barrier(0);
}
template <int DQK, int WHAT, int NFV>
__device__ __forceinline__ void pp_seg_run(f32x16& S0, f32x16& S1, f32x16 (&o)[4], const bf16x8 (&qr)[DQK / 16], const bf16x8 (&pa)[4], bf16x8 (&F)[NFV], const int (&ka)[DQK / 16], int va, f32x16& lsum, const f32x16& negm) {
  static_assert(NFV == PPA<DQK, WHAT>::NF, "fragment array size");
  using P = PPA<DQK, WHAT>;
  __builtin_amdgcn_sched_barrier(0);
  P::template step<0>(S0, S1, o, qr, pa, F, ka, va, negm);
  if constexpr (WHAT >= 1) {
    bf16x8 ones; { const u32x4 w = {0x3f803f80u, 0x3f803f80u, 0x3f803f80u, 0x3f803f80u}; ones = __builtin_bit_cast(bf16x8, w); }
#pragma unroll
    for (int ks = 0; ks < 4; ++ks) lsum = __builtin_amdgcn_mfma_f32_32x32x16_bf16(pa[ks], ones, lsum, 0, 0, 0);
  }
}
template <int DQK, int LDQ, int LDK, int LDV, int LDO, int MODE>
__device__ __forceinline__ void attn_pp_body(const bf16_t* __restrict__ Qb, const bf16_t* __restrict__ Kh, const bf16_t* __restrict__ Vh, const EpiArgs ea, int seq, LAS char* lds, int tstart) {
  constexpr int SHM_K = KVBLK * DQK * 2, SHM_VV = KVBLK * DV * 2, NKP = DQK == 128 ? 2 : 1;
  int tid_ = threadIdx.x; asm volatile("" : "+v"(tid_));
  const int tid = tid_, wid = __builtin_amdgcn_readfirstlane(tid >> 6), lane = tid & 63, r32 = lane & 31, hi = lane >> 5, grp = PP_GRP(wid);
  LAS float* al_l = (LAS float*)(lds + PP_WSOFF) + wid * 64; LAS float* li_l = al_l + 32;
  int koff[NKP], voff[2];
#pragma unroll
  for (int i = 0; i < NKP; ++i) { const int o = (wid + 8 * i) * 1024 + lane * 16;
    if constexpr (DQK == 128) { const int row = o >> 8, cb = (o & 255) ^ ((row & 15) << 4); koff[i] = row * LDK + (cb >> 1); }
    else { const int row = o >> 7, cb = (o & 127) ^ (((row >> 1) & 7) << 4); koff[i] = row * LDK + (cb >> 1); } }
#pragma unroll
  for (int i = 0; i < 2; ++i) { const int o = (wid + 8 * i) * 1024 + lane * 16, sub = o >> 9, within = (o & 511) >> 1;
    const int kk = (sub >> 2) * 8 + (within >> 5), c = (sub & 3) * 32 + (within & 31), s_ = swap23(kk), p_ = s_ & 15;
    const int key = (s_ & ~15) + (p_ & 3) + ((p_ >> 2) & 1) * 8 + ((p_ >> 3) & 1) * 4; voff[i] = key * LDV + c; }
#define DMA_K(t, slot) do { _Pragma("unroll") for (int i_ = 0; i_ < NKP; ++i_) __builtin_amdgcn_global_load_lds((const unsigned*)(Kh + (size_t)(t) * KVBLK * LDK + koff[i_]), \
    (LAS unsigned*)(lds + (slot) * SHM_K + (wid + 8 * i_) * 1024), 16, 0, 0); } while (0)
#define DMA_V(t, slot) do { _Pragma("unroll") for (int i_ = 0; i_ < 2; ++i_) __builtin_amdgcn_global_load_lds((const unsigned*)(Vh + (size_t)(t) * KVBLK * LDV + voff[i_]), \
    (LAS unsigned*)(lds + PP_VOFF + (slot) * SHM_VV + (wid + 8 * i_) * 1024), 16, 0, 0); } while (0)
  const int NT = seq / KVBLK, TM = NT - 1;
  DMA_K(tstart & TM, 0); DMA_V(tstart & TM, 0); DMA_K((tstart + 1) & TM, 1); DMA_V((tstart + 1) & TM, 1); DMA_K((tstart + 2) & TM, 2);
  bf16x8 qr[DQK / 16];
  { const bf16_t* Qw = Qb + (long)(wid * QBLK + r32) * LDQ + hi * 8;
#pragma unroll
    for (int d0 = 0; d0 < DQK / 16; ++d0) qr[d0] = *reinterpret_cast<const bf16x8*>(Qw + d0 * 16); }
  float m_ref = 0.f; f32x16 o[4] = {}; f32x16 lsum = {}; f32x16 negm = {}; f32x16 S0, S1; bf16x8 pa[4] = {};
  const int ldsb = (int)(unsigned)(size_t)lds;
  const int vrb = ldsb + PP_VOFF + v_rd_base(lane);
  int kz[DQK / 16];
#pragma unroll
  for (int d0 = 0; d0 < DQK / 16; ++d0) kz[d0] = ldsb + kswz<DQK>(r32, d0 * 32 + hi * 16);
  PP_WAITBAR();
  if (grp == 1) PP_BAR();
#define PP_FADD(a, b) ((a) + (b))
#define PK8(P, BASE, OUT) do { const u32x4 w_ = {cvtpk(P[BASE + 0], P[BASE + 1]), cvtpk(P[BASE + 2], P[BASE + 3]), cvtpk(P[BASE + 4], P[BASE + 5]), cvtpk(P[BASE + 6], P[BASE + 7])}; OUT = __builtin_bit_cast(bf16x8, w_); } while (0)
#if defined(PROBE_B)
#define PROBE_B_CODE { float d_ = m_ref; _Pragma("unroll") for (int q_ = 0; q_ < 64; ++q_) d_ = __builtin_fmaf(d_, 1.0001f, 0.5f); asm volatile("" :: "v"(d_)); }
#else
#define PROBE_B_CODE
#endif
#define PP_SEG_B(j, FIRST, sm1, sp2) do { \
    if ((j) + 3 < NT) DMA_K((tstart + (j) + 3) & TM, sm1); \
    if ((j) + 2 < NT) DMA_V((tstart + (j) + 2) & TM, sp2); \
    float a = fmaxf(fmaxf(S0[0], S0[1]), S1[0]), b = fmaxf(fmaxf(S0[2], S0[3]), S1[1]); a = fmaxf(fmaxf(a, S1[2]), S1[3]); \
    _Pragma("unroll") for (int r = 4; r < 16; r += 4) { a = fmaxf(fmaxf(a, S0[r]), S0[r + 1]); b = fmaxf(fmaxf(b, S0[r + 2]), S0[r + 3]); a = fmaxf(fmaxf(a, S1[r]), S1[r + 1]); b = fmaxf(fmaxf(b, S1[r + 2]), S1[r + 3]); } \
    float rm = fmaxf(a, b); \
    { auto rr = __builtin_amdgcn_permlane32_swap(__float_as_uint(rm), __float_as_uint(rm), false, false); rm = fmaxf(__uint_as_float(rr[0]), __uint_as_float(rr[1])); } \
    if (!PP_NEGM(DQK)) rm -= m_ref;                                  \
    if (FIRST) { m_ref += rm; if (PP_NEGM(DQK)) { _Pragma("unroll") for (int r = 0; r < 16; ++r) { S0[r] -= rm; S1[r] -= rm; negm[r] = -m_ref; } } }     \
    else if (__any(rm > THRL)) {                                     \
      const float dl = fmaxf(rm, 0.f); m_ref += dl; \
      if (PP_NEGM(DQK)) { _Pragma("unroll") for (int r = 0; r < 16; ++r) { S0[r] -= dl; S1[r] -= dl; negm[r] = -m_ref; } } \
      const float al = __builtin_amdgcn_exp2f(-dl); \
      if (hi == 0) al_l[r32] = al; asm volatile("s_waitcnt lgkmcnt(0)" ::: "memory"); \
      _Pragma("unroll") for (int r = 0; r < 16; ++r) { const float f_ = al_l[crow(r, hi)]; lsum[r] *= f_; _Pragma("unroll") for (int d = 0; d < 4; ++d) o[d][r] *= f_; } } \
    _Pragma("unroll") for (int r = 0; r < 16; ++r) { S0[r] = __builtin_amdgcn_exp2f(PP_NEGM(DQK) ? S0[r] : S0[r] - m_ref); S1[r] = __builtin_amdgcn_exp2f(PP_NEGM(DQK) ? S1[r] : S1[r] - m_ref); } \
    PK8(S0, 0, pa[0]); PK8(S0, 8, pa[1]); PK8(S1, 0, pa[2]); PK8(S1, 8, pa[3]); \
    PROBE_B_CODE \
  } while (0)
  { bf16x8 F0[PPA<DQK, 0>::NF]; pp_seg_pre<DQK, 0>(F0, kz, vrb); pp_seg_run<DQK, 0>(S0, S1, o, qr, pa, F0, kz, vrb, lsum, negm); }
  PP_WAITBAR();
  bf16x8 F[PPA<DQK, 1>::NF];
  PP_SEG_B(0, true, PP_NS - 1, 2);
#pragma unroll
  for (int z = 0; z < DQK / 16; ++z) kz[z] += SHM_K;
  pp_seg_pre<DQK, 1>(F, kz, vrb);
  PP_BAR();
  int sj = 1;
  for (int j = 1; j < NT; ++j) {
    const int sm1 = (sj + PP_NS - 1) & (PP_NS - 1), sp1 = (sj + 1) & (PP_NS - 1), sp2 = (sj + 2) & (PP_NS - 1);
    pp_seg_run<DQK, 1>(S0, S1, o, qr, pa, F, kz, vrb + sm1 * SHM_VV, lsum, negm);
    PP_WAITBAR();
    PP_SEG_B(j, false, sm1, sp2);
#pragma unroll
    for (int z = 0; z < DQK / 16; ++z) kz[z] += (sp1 == 0) ? -(PP_NS - 1) * SHM_K : SHM_K;
    if (j + 1 < NT) pp_seg_pre<DQK, 1>(F, kz, vrb);
    PP_BAR();
    sj = sp1;
  }
#undef PP_SEG_B
#undef PK8
#undef PP_FADD
  { bf16x8 F2[PPA<DQK, 2>::NF]; const int vd = vrb + ((sj + PP_NS - 1) & (PP_NS - 1)) * SHM_VV; pp_seg_pre<DQK, 2>(F2, kz, vd); pp_seg_run<DQK, 2>(S0, S1, o, qr, pa, F2, kz, vd, lsum, negm); }
  asm volatile("" ::: "memory");
  if (grp == 0) PP_BAR();
  float rli[16];
#pragma unroll
  for (int r = 0; r < 16; ++r) rli[r] = __builtin_amdgcn_rcpf(lsum[r]);
  if constexpr (MODE == 0) {
    bf16_t* Ow = ea.O + (long)(wid * QBLK) * LDO;
#pragma unroll
    for (int r = 0; r < 16; ++r) { const int orow = crow(r, hi);
#pragma unroll
      for (int d0 = 0; d0 < 4; ++d0) Ow[(long)orow * LDO + d0 * 32 + r32] = (bf16_t)(cvtpk(o[d0][r] * rli[r], 0.f) & 0xffffu); }
  } else if constexpr (MODE == 1) {
    float* Sw = ea.S0 + (wid * QBLK) * 128;
#pragma unroll
    for (int r = 0; r < 16; ++r) { const int orow = crow(r, hi);
#pragma unroll
      for (int d0 = 0; d0 < 4; ++d0) Sw[orow * 128 + d0 * 32 + r32] = o[d0][r] * rli[r]; }
  } else {
    const volatile float* Sw = ea.S0 + (wid * QBLK) * 128;
    bf16_t* Ow = ea.O + (long)(wid * QBLK) * LDO;
    float gv[4];
#pragma unroll
    for (int d0 = 0; d0 < 4; ++d0) gv[d0] = ea.g[d0 * 32 + r32] * (1.0f - LAM_INIT);
#pragma unroll
    for (int r = 0; r < 16; ++r) { const int orow = crow(r, hi); float dv[4]; float ss = 0.f;
#pragma unroll
      for (int d0 = 0; d0 < 4; ++d0) { dv[d0] = Sw[orow * 128 + d0 * 32 + r32] - ea.lam * (o[d0][r] * rli[r]); ss += dv[d0] * dv[d0]; }
#pragma unroll
      for (int x = 1; x < 32; x <<= 1) ss += __shfl_xor(ss, x);
      const float rstd = 1.0f / sqrtf(ss * (1.0f / 128.0f) + EPS);
#pragma unroll
      for (int d0 = 0; d0 < 4; ++d0) Ow[(long)orow * LDO + d0 * 32 + r32] = (bf16_t)(cvtpk(dv[d0] * rstd * gv[d0], 0.f) & 0xffffu); }
  }
  PP_WAITBAR();
#undef DMA_K
#undef DMA_V
}
#undef SBAR
}

#define XB_TMO      128
#define XB_XCNT(j)  (256  + 64 * (j))
#define XB_XSUB(j)  (1280 + 64 * (j))
#define XB_XGEN(j)  (2304 + 64 * (j))
#define XB_TOP      3328
#define XB_TOPGEN   3392
#define XCD_BAR_WORDS 3456
#define XB_SPIN_CAP (1u << 18)

__device__ __forceinline__ unsigned xb_ld(unsigned* p)              { return __hip_atomic_load(p, __ATOMIC_RELAXED, __HIP_MEMORY_SCOPE_AGENT); }
__device__ __forceinline__ unsigned xb_add(unsigned* p, unsigned v) { return __hip_atomic_fetch_add(p, v, __ATOMIC_RELAXED, __HIP_MEMORY_SCOPE_AGENT); }
__device__ __forceinline__ unsigned xb_xcc_id() { return (unsigned)__builtin_amdgcn_s_getreg((3 << 11) | 20) & 0xFu; }
#define XB_SPIN(cond, bar) do { unsigned _sp = 0; while (cond) { __builtin_amdgcn_s_sleep(1); \
    if ((++_sp & 255u) == 0u) { if (xb_ld(&(bar)[XB_TMO])) break; if (_sp > XB_SPIN_CAP) { atomicAdd(&(bar)[XB_TMO], 1u); break; } } } } while (0)

struct XcdBarrier {
    unsigned* bar; unsigned x;
    volatile LAS unsigned* st;
};

__device__ __forceinline__ XcdBarrier xcd_barrier_post(unsigned* bar, volatile LAS unsigned* st) {
    XcdBarrier b; b.bar = bar; b.x = xb_xcc_id(); b.st = st;
    if (threadIdx.x == 0) (void)xb_add(&bar[XB_XCNT(b.x)], 1u);
    return b;
}
__device__ __forceinline__ void xcd_barrier_complete(unsigned* bar, unsigned x, unsigned& nloc, unsigned& nx) {
    const unsigned G = gridDim.x * gridDim.y * gridDim.z;
    unsigned sum, cnt, mine, sp = 0u;
    for (;;) {
        sum = 0u; cnt = 0u; mine = 0u;
#pragma unroll
        for (unsigned j = 0; j < 16; ++j) { const unsigned c = xb_ld(&bar[XB_XCNT(j)]); sum += c; cnt += (c > 0u) ? 1u : 0u; mine = (j == x) ? c : mine; }
        if (sum == G) break;
        __builtin_amdgcn_s_sleep(1);
        if ((++sp & 255u) == 0u) { if (xb_ld(&bar[XB_TMO])) break; if (sp > XB_SPIN_CAP) { atomicAdd(&bar[XB_TMO], 1u); break; } }
    }
    nloc = mine > 0u ? mine : 1u; nx = cnt > 0u ? cnt : 1u;
}

__device__ __forceinline__ void xcd_barrier(const XcdBarrier& b) {
    asm volatile("s_waitcnt vmcnt(0)" ::: "memory");
    __syncthreads();
    if (threadIdx.x == 0) {
        unsigned* bar = b.bar;
        __builtin_amdgcn_s_waitcnt(0);
        unsigned nloc = b.st[0], nx = b.st[1];
        if (nloc == 0u) { xcd_barrier_complete(bar, b.x, nloc, nx); b.st[0] = nloc; b.st[1] = nx; }
        const unsigned old = xb_add(&bar[XB_XSUB(b.x)], 1u);
        const unsigned gen = old / nloc;
        if (old + 1u == (gen + 1u) * nloc) {
            __builtin_amdgcn_fence(__ATOMIC_RELEASE, "agent");
            asm volatile("s_waitcnt vmcnt(0)" ::: "memory");
            const unsigned og = xb_add(&bar[XB_TOP], 1u);
            const unsigned tg = og / nx;
            if (og + 1u == (tg + 1u) * nx) xb_add(&bar[XB_TOPGEN], 1u);
            else XB_SPIN(xb_ld(&bar[XB_TOPGEN]) == tg, bar);
            __builtin_amdgcn_fence(__ATOMIC_ACQUIRE, "agent");
            xb_add(&bar[XB_XGEN(b.x)], 1u);
            asm volatile("s_waitcnt vmcnt(0)" ::: "memory");
        } else {
            XB_SPIN(xb_ld(&bar[XB_XGEN(b.x)]) == gen, bar);
            __builtin_amdgcn_fence(__ATOMIC_ACQUIRE, "agent");
            asm volatile("s_waitcnt vmcnt(0)" ::: "memory");
        }
    }
    __syncthreads();
}

constexpr int LDS_BYTES = 131072 + 8192;
#ifndef EN_MASK
#define EN_MASK 0xFFFF
#endif
constexpr int ENM = EN_MASK;
constexpr int NPH = 46;
struct Ctx { LAS unsigned char* lds; char* ldsg; int tid, lane, wave, G, bid, gw, NGW; };

__host__ __device__ inline bool phase_active(int ph) {
    if (ph == 0 || ph == NPH - 1) return true;
    const int i = (ph - 1) / 11, s = (ph - 1) % 11, kind = i & 3;
    if (s < 4 || s > 7) return true;
    const int nm = (kind == 0) ? 2 : (kind == 2 ? 4 : 3);
    return (s - 4) < nm;
}

#ifndef PROBE_DUP
#define PROBE_DUP 0
#endif
__host__ __device__ inline bool probe_dup(int ph) {
    if (ph == 0) return PROBE_DUP == 6;
    if (ph == NPH - 1) return false;
    const int i = (ph - 1) / 11, s = (ph - 1) % 11, kind = i & 3;
    if (PROBE_DUP == 1) return s == 1 || s == 9;
    if (PROBE_DUP == 2) return s == 0 || s == 3 || s == 8;
    if (PROBE_DUP == 3) return kind == 1 && s == 5;
    if (PROBE_DUP == 4) return kind == 2 && s == 6;
    if (PROBE_DUP == 5) return s == 4 && kind != 0;
    if (PROBE_DUP == 7) return i == 0 && s == 2;
    return false;
}
__device__ __forceinline__ int dest_row(int mode, int n0) {
    if (mode == 0) return n0;
    if (mode == 1) { const int h = n0 >= DFF ? 1 : 0; const int j = n0 - h * DFF; return (j >> 7) * 256 + h * 128 + (j & 127); }
    if (n0 < 1024) return 2048 + n0;
    const int h = n0 >= 2048 ? 1 : 0; const int j = n0 - 1024 - h * 1024; return (j >> 7) * 256 + h * 128 + (j & 127);
}
__device__ __forceinline__ void transpose_item(const float* W, int K, int N, bf16_t* WT, int k0, int n0, int dn0, LAS float* scr, int lane) {
#pragma unroll 8
    for (int i = 0; i < 32; ++i) { const int kk = 2 * i + (lane >> 5); scr[kk * 33 + (lane & 31)] = W[(size_t)(k0 + kk) * N + n0 + (lane & 31)]; }
    LDS_WAIT(); asm volatile("" ::: "memory");
    const int c = lane & 7;
#pragma unroll
    for (int j = 0; j < 4; ++j) { const int n = (lane >> 3) + 8 * j; const LAS float* s = scr + (8 * c) * 33 + n;
        v4u o; o.x = cvt_pk_bf16(s[0 * 33], s[1 * 33]); o.y = cvt_pk_bf16(s[2 * 33], s[3 * 33]); o.z = cvt_pk_bf16(s[4 * 33], s[5 * 33]); o.w = cvt_pk_bf16(s[6 * 33], s[7 * 33]);
        *(v4u*)(WT + (size_t)(dn0 + n) * K + k0 + 8 * c) = o; }
    LDS_WAIT(); asm volatile("" ::: "memory");
}
template <class AP> __device__ __forceinline__ void prologue(const Ctx& F, AP a) {
    unsigned char* ws = a->ws;
    {
        LAS float* cact = (LAS float*)F.lds; LAS float* red = cact + 2048;
        const float* c = a->in[1];
        for (int u = F.tid; u < 2048; u += NTHR) cact[u] = silu_f(c[u]);
        __syncthreads();
        float* MODV = (float*)(ws + WS_MODV);
        for (int item = F.bid; item < 144; item += F.G) {
            const int i = item / 36, cb = item % 36;
            const float* W = a->in[2] + (size_t)i * 1024 * 9216 + cb * 256 + 4 * F.lane;
            f32x4 a0 = {0.f, 0.f, 0.f, 0.f}, a1 = a0;
            const int kbeg = F.wave * 128;
#pragma unroll 8
            for (int k = kbeg; k < kbeg + 128; ++k) { const f32x4 w = *(const f32x4*)(W + (size_t)k * 9216); a0 += w * cact[k]; a1 += w * cact[1024 + k]; }
            *(LAS f32x4*)(red + (F.wave * 2 + 0) * 256 + 4 * F.lane) = a0;
            *(LAS f32x4*)(red + (F.wave * 2 + 1) * 256 + 4 * F.lane) = a1;
            __syncthreads();
            { const int b = F.tid >> 8, col = F.tid & 255; float s = a->in[3][i * 9216 + cb * 256 + col];
#pragma unroll
              for (int w = 0; w < 8; ++w) s += red[(w * 2 + b) * 256 + col];
              MODV[(size_t)(i * 2 + b) * 9216 + cb * 256 + col] = s; }
            __syncthreads();
        }
        __syncthreads();
    }
    if (F.bid == 0) { unsigned* bw = (unsigned*)(ws + WS_BAR); int t0 = threadIdx.x; asm volatile("" : "+v"(t0)); for (int u = t0; u < XCD_BAR_WORDS; u += NTHR) bw[u] = 0u; }
    {
        float* R1 = (float*)(ws + WS_ROPE1); float* AX = (float*)(ws + WS_AXR);
        const int gt = F.gw * 64 + F.lane, NT = F.NGW * 64;
        for (int idx = gt; idx < SEQ * 8; idx += NT) { const int t = idx >> 3, j = idx & 7; float c, s; sincos_acc((float)t * INV1[j], c, s); R1[t * 16 + j] = c; R1[t * 16 + 8 + j] = s; }
        for (int idx = gt; idx < 256 * 32; idx += NT) { const int p = idx >> 5, f = idx & 31; float c, s; sincos_acc((float)p * INV2[f], c, s); AX[p * 64 + f] = c; AX[p * 64 + 32 + f] = s; }
    }
    {
        LAS float* scr = (LAS float*)(F.lds + F.wave * 16384);
        int base = 0;
        for (int mat = 0; mat < 26; ++mat) {
            const float* src; bf16_t* dst; int K, N, mode = 0;
            if (mat < 8)       { src = a->in[5] + (size_t)mat * D * 2 * DFF; dst = (bf16_t*)(ws + WS_WGU + (size_t)mat * SZ_WGU1); K = D; N = 2 * DFF; mode = 1; }
            else if (mat < 16) { src = a->in[6] + (size_t)(mat - 8) * DFF * D; dst = (bf16_t*)(ws + WS_WDN + (size_t)(mat - 8) * SZ_WDN1); K = DFF; N = D; }
            else if (mat < 20) { src = a->in[7] + (size_t)(mat - 16) * 65536; dst = (bf16_t*)(ws + WS_WPOOL) + (size_t)(mat - 16) * 65536; K = 256; N = 256; }
            else if (mat == 20) { src = a->in[9];  dst = (bf16_t*)(ws + WS_WDQKV); K = D; N = 3072; }
            else if (mat == 21) { src = a->in[12]; dst = (bf16_t*)(ws + WS_WDO);   K = D; N = D; }
            else if (mat == 22) { src = a->in[13]; dst = (bf16_t*)(ws + WS_WGQKV); K = D; N = 1536; }
            else if (mat == 23) { src = a->in[16]; dst = (bf16_t*)(ws + WS_WGO);   K = D; N = D; }
            else if (mat == 24) { src = a->in[17]; dst = (bf16_t*)(ws + WS_WCIN);  K = D; N = 3072; mode = 2; }
            else                { src = a->in[19]; dst = (bf16_t*)(ws + WS_WCOUT); K = D; N = D; }
            const int nblk = N / 32, nitems = (K / 64) * nblk;
            int first = (F.gw - base) % F.NGW; if (first < 0) first += F.NGW;
            for (int it = first; it < nitems; it += F.NGW) { const int kb = it / nblk, nb = it % nblk; transpose_item(src, K, N, dst, kb * 64, nb * 32, dest_row(mode, nb * 32), scr, F.lane); }
            base = (base + nitems) % F.NGW;
        }
    }
}

template <bool FINAL, bool XF32>
__device__ __forceinline__ void norm_phase(const Ctx& F, const void* xv, bf16_t* xn, float* xo, const float* g, const float* sh, const float* sc) {
    for (int b = 0; b < BATCH; ++b) {
        f32x4 A[4], Bv[4];
#pragma unroll
        for (int j = 0; j < 4; ++j) { const int col = 4 * F.lane + 256 * j; A[j] = *(const f32x4*)(g + col);
            if (!FINAL) { A[j] = A[j] * (*(const f32x4*)(sc + (size_t)b * 9216 + col) + 1.0f); Bv[j] = *(const f32x4*)(sh + (size_t)b * 9216 + col); } }
        for (int m0 = b * SEQ + F.gw; m0 < (b + 1) * SEQ; m0 += 2 * F.NGW) {
            f32x4 v[2][4]; float s[2] = {0.f, 0.f};
#pragma unroll
            for (int q = 0; q < 2; ++q) { const size_t m = (size_t)(m0 + q * F.NGW);
                if (XF32) { const f32x4* xr = (const f32x4*)((const float*)xv + m * D) + F.lane;
#pragma unroll
                    for (int j = 0; j < 4; ++j) v[q][j] = xr[64 * j];
                } else { const v2u* xr = (const v2u*)((const bf16_t*)xv + m * D) + F.lane;
#pragma unroll
                    for (int j = 0; j < 4; ++j) v[q][j] = half4_to_f32(xr[64 * j]); } }
#pragma unroll
            for (int q = 0; q < 2; ++q)
#pragma unroll
                for (int j = 0; j < 4; ++j) s[q] += (v[q][j].x * v[q][j].x + v[q][j].y * v[q][j].y) + (v[q][j].z * v[q][j].z + v[q][j].w * v[q][j].w);
#pragma unroll
            for (int q = 0; q < 2; ++q) { const size_t m = (size_t)(m0 + q * F.NGW);
                const float rstd = 1.0f / sqrtf(wave_sum(s[q]) * (1.0f / D) + EPS);
                if (FINAL) { f32x4* o = (f32x4*)(xo + m * D) + F.lane;
#pragma unroll
                    for (int j = 0; j < 4; ++j) o[64 * j] = v[q][j] * rstd * A[j];
                } else { v2u* o = (v2u*)(xn + m * D) + F.lane;
#pragma unroll
                    for (int j = 0; j < 4; ++j) { const f32x4 h = v[q][j] * rstd * A[j] + Bv[j]; v2u w; w.x = cvt_pk_bf16(h.x, h.y); w.y = cvt_pk_bf16(h.z, h.w); o[64 * j] = w; } } }
        }
    }
}
__device__ __forceinline__ void unpack_bf8(const v4u w, float (&f)[8]) { f[0] = bf_lo(w.x); f[1] = bf_hi(w.x); f[2] = bf_lo(w.y); f[3] = bf_hi(w.y); f[4] = bf_lo(w.z); f[5] = bf_hi(w.z); f[6] = bf_lo(w.w); f[7] = bf_hi(w.w); }
__device__ __forceinline__ void pooldiff_phase(const Ctx& F, const bf16_t* xn, bf16_t* pd) {
    const int gt = F.gw * 64 + F.lane, NT = F.NGW * 64;
    for (int task = gt; task < (M / 32) * 128; task += NT) {
        const int c8 = task & 127, m0 = (task >> 7) * 32, t0 = m0 & (SEQ - 1), b0 = m0 - t0, hw = 1 << (c8 >> 5);
        const bf16_t* col = xn + (size_t)b0 * D + c8 * 8;
        float acc[8] = {0.f, 0.f, 0.f, 0.f, 0.f, 0.f, 0.f, 0.f};
        for (int d = -8; d < 8; ++d) { const int r = t0 + d; if (d >= -hw && d < hw && r >= 0 && r < SEQ) { float f[8]; unpack_bf8(*(const v4u*)(col + (size_t)r * D), f);
#pragma unroll
                for (int e = 0; e < 8; ++e) acc[e] += f[e]; } }
        for (int i = 0; i < 32; ++i) { const int t = t0 + i;
            const int lo = t - hw < 0 ? 0 : t - hw, hi = t + hw > SEQ ? SEQ : t + hw; const float inv = 1.0f / (float)(hi - lo);
            float sf[8]; unpack_bf8(*(const v4u*)(col + (size_t)t * D), sf);
            v4u o; o.x = cvt_pk_bf16(acc[0] * inv - sf[0], acc[1] * inv - sf[1]); o.y = cvt_pk_bf16(acc[2] * inv - sf[2], acc[3] * inv - sf[3]);
            o.z = cvt_pk_bf16(acc[4] * inv - sf[4], acc[5] * inv - sf[5]); o.w = cvt_pk_bf16(acc[6] * inv - sf[6], acc[7] * inv - sf[7]);
            *(v4u*)(pd + (size_t)(b0 + t) * D + c8 * 8) = o;
            if (t - hw >= 0) { float f[8]; unpack_bf8(*(const v4u*)(col + (size_t)(t - hw) * D), f);
#pragma unroll
                for (int e = 0; e < 8; ++e) acc[e] -= f[e]; }
            if (t + hw < SEQ) { float f[8]; unpack_bf8(*(const v4u*)(col + (size_t)(t + hw) * D), f);
#pragma unroll
                for (int e = 0; e < 8; ++e) acc[e] += f[e]; }
        }
    }
}
__device__ __forceinline__ void conv_phase(const Ctx& F, const bf16_t* z, const bf16_t* gbuf, const float* wc, bf16_t* ca) {
    const int gt = F.gw * 64 + F.lane, NT = F.NGW * 64;
    for (int task = gt; task < (M / 32) * 128; task += NT) {
        const int c8 = task & 127, m0 = (task >> 7) * 32, t0 = m0 & (SEQ - 1);
        float w0[8], w1[8], w2[8];
#pragma unroll
        for (int e = 0; e < 8; ++e) { w0[e] = wc[c8 * 8 + e]; w1[e] = wc[D + c8 * 8 + e]; w2[e] = wc[2 * D + c8 * 8 + e]; }
        const v4u zero = {0u, 0u, 0u, 0u};
        float zm[8], z0[8], zp[8], gv[8];
        unpack_bf8(t0 > 0 ? *(const v4u*)(z + (size_t)(m0 - 1) * D + c8 * 8) : zero, zm);
        unpack_bf8(*(const v4u*)(z + (size_t)m0 * D + c8 * 8), z0);
        for (int i = 0; i < 32; ++i) { const int m = m0 + i, t = t0 + i;
            unpack_bf8(t < SEQ - 1 ? *(const v4u*)(z + (size_t)(m + 1) * D + c8 * 8) : zero, zp);
            unpack_bf8(*(const v4u*)(gbuf + (size_t)m * D + c8 * 8), gv);
            float r[8];
#pragma unroll
            for (int e = 0; e < 8; ++e) r[e] = gv[e] * (w0[e] * zm[e] + w1[e] * z0[e] + w2[e] * zp[e]);
            v4u o; o.x = cvt_pk_bf16(r[0], r[1]); o.y = cvt_pk_bf16(r[2], r[3]); o.z = cvt_pk_bf16(r[4], r[5]); o.w = cvt_pk_bf16(r[6], r[7]);
            *(v4u*)(ca + (size_t)m * D + c8 * 8) = o;
#pragma unroll
            for (int e = 0; e < 8; ++e) { zm[e] = z0[e]; z0[e] = zp[e]; }
        }
    }
}
__device__ __forceinline__ void qknorm_phase(const Ctx& F, bf16_t* Q, bf16_t* K, const float* qg, const float* kg, const float* ax) {
    const int gt = F.gw * 64 + F.lane, NT = F.NGW * 64, sub = F.lane & 15;
    float gq[8], gk[8];
#pragma unroll
    for (int e = 0; e < 8; ++e) { gq[e] = qg[sub * 8 + e]; gk[e] = kg[sub * 8 + e]; }
    for (int task = gt >> 4; task < M * 10; task += NT >> 4) {
        const int m = task / 10, hh = task % 10, t = m & (SEQ - 1);
        bf16_t* p = hh < 8 ? Q + (size_t)m * 1024 + hh * 128 + sub * 8 : K + (size_t)m * 256 + (hh - 8) * 128 + sub * 8;
        const v4u w = *(const v4u*)p;
        float v[8] = {bf_lo(w.x), bf_hi(w.x), bf_lo(w.y), bf_hi(w.y), bf_lo(w.z), bf_hi(w.z), bf_lo(w.w), bf_hi(w.w)};
        float ss = 0.f;
#pragma unroll
        for (int e = 0; e < 8; ++e) ss += v[e] * v[e];
        ss += __shfl_xor(ss, 1); ss += __shfl_xor(ss, 2); ss += __shfl_xor(ss, 4); ss += __shfl_xor(ss, 8);
        const float rstd = 1.0f / sqrtf(ss * (1.0f / 128.0f) + EPS);
#pragma unroll
        for (int e = 0; e < 8; ++e) v[e] = v[e] * rstd * (hh < 8 ? gq[e] : gk[e]);
        const int pos = sub < 8 ? (t >> 6) : (t & 63);
        const float* cs = ax + pos * 64 + (sub & 3) * 8;
        const bool second = (sub & 4) != 0;
        const float qs = hh < 8 ? 0.12751743074602467f : 1.0f;
        float o[8];
#pragma unroll
        for (int e = 0; e < 8; ++e) { const float pv = __shfl_xor(v[e], 4); const float c = cs[e], s = cs[32 + e]; o[e] = (second ? (v[e] * c + pv * s) : (v[e] * c - pv * s)) * qs; }
        v4u ow; ow.x = cvt_pk_bf16(o[0], o[1]); ow.y = cvt_pk_bf16(o[2], o[3]); ow.z = cvt_pk_bf16(o[4], o[5]); ow.w = cvt_pk_bf16(o[6], o[7]);
        *(v4u*)p = ow;
    }
}

__global__ void __launch_bounds__(NTHR, 2) fwd_kernel(Args a) {
    extern __shared__ __attribute__((aligned(16))) unsigned char lds_raw[];
    const int ph_lo = a.ph_lo, ph_hi = a.ph_hi;
#define XB_ST() ((volatile LAS unsigned*)((LAS unsigned char*)lds_raw + LDS_BYTES - 64))
    if (threadIdx.x == 0) { XB_ST()[0] = 0u; XB_ST()[1] = 0u; }
    __syncthreads();
#define PHASE_SETUP() \
        KArgs ap = (KArgs)__builtin_amdgcn_kernarg_segment_ptr();     \
        asm volatile("" : "+s"(ap)); \
        unsigned char* ws = ap->ws; \
        float* MODV = (float*)(ws + WS_MODV); \
        bf16_t* XN = (bf16_t*)(ws + WS_XN); bf16_t* ACT = (bf16_t*)(ws + WS_ACT); \
        bf16_t* QB = (bf16_t*)(ws + WS_Q); bf16_t* KB = (bf16_t*)(ws + WS_K); bf16_t* VB = (bf16_t*)(ws + WS_V); bf16_t* AO = (bf16_t*)(ws + WS_AO); \
        float* X = ap->out; bf16_t* XB = (bf16_t*)(ws + WS_XB); \
        Ctx F;                                                      \
        F.lds = (LAS unsigned char*)lds_raw; F.ldsg = (char*)lds_raw; \
        { int t_ = threadIdx.x; asm volatile("" : "+v"(t_)); F.tid = t_; } \
        F.lane = F.tid & 63; F.wave = __builtin_amdgcn_readfirstlane(F.tid >> 6); \
        F.G = gridDim.x; F.bid = blockIdx.x; F.gw = F.bid * NWAVES + F.wave; F.NGW = F.G * NWAVES; \
        (void)MODV; (void)XN; (void)ACT; (void)QB; (void)KB; (void)VB; (void)AO; (void)X; (void)XB;
#define SEAM(PH, MORE) do { if (MORE) { \
            const bool one_launch_ = (ap->ph_lo == 0 && ap->ph_hi == NPH); \
            if (one_launch_ && (PH) > 0) { XcdBarrier xb; xb.bar = (unsigned*)(ap->ws + WS_BAR); xb.x = xb_xcc_id(); xb.st = XB_ST(); xcd_barrier(xb); } \
            else { cg::this_grid().sync(); \
                if (one_launch_) { unsigned* bw = (unsigned*)(ap->ws + WS_BAR); if (threadIdx.x == 0) (void)xb_add(&bw[XB_XCNT(xb_xcc_id())], 1u); } } } } while (0)
    int ph = ph_lo;
    if (ph == 0 && ph < ph_hi) { PHASE_SETUP(); if constexpr (ENM & 1) prologue(F, ap); SEAM(0, 1 < ph_hi); ph = 1; }
    int rep = 0; (void)rep;
    for (; ph < ph_hi; ++ph) {
        if (!phase_active(ph)) continue;
        PHASE_SETUP();
        if (false) {}
        else if (ph == NPH - 1) { if constexpr (ENM & 2) norm_phase<true, false>(F, XB, nullptr, X, ap->in[20], nullptr, nullptr); }
        else {
            const int i = (ph - 1) / 11, s = (ph - 1) % 11, kind = i & 3;
            const float* mv = MODV + (size_t)i * 2 * 9216;
            if (s == 0 || s == 3 || s == 8) { if constexpr (ENM & 2) {
                const int j = s == 0 ? 0 : (s == 3 ? 1 : 2);
                if (i == 0 && s == 0) norm_phase<false, true>(F, ap->in[0], XN, nullptr, ap->in[4] + (size_t)(i * 3 + j) * D, mv + (3 * j) * D, mv + (3 * j + 1) * D);
                else norm_phase<false, false>(F, XB, XN, nullptr, ap->in[4] + (size_t)(i * 3 + j) * D, mv + (3 * j) * D, mv + (3 * j + 1) * D); }
            } else if (s == 1 || s == 9) { if constexpr (ENM & 4) {
                const int f = s == 1 ? 0 : 1;
                pg8::Gemm g{XN, (const bf16_t*)(ws + WS_WGU + (size_t)(i * 2 + f) * SZ_WGU1), M, 2 * DFF, D, D, D, 0};
                pg8::StaticOrder S; S.init(M, 2 * DFF, F.G, F.bid);
                pg8::EpiSwiglu E{ACT, DFF};
                pg8::gemm_phase<pg8::EpiSwiglu, pg8::StaticOrder, true, true>(F.lds, g, S, E); }
            } else if (s == 2 || s == 10) { if constexpr (ENM & 8) {
                const int f = s == 2 ? 0 : 1;
                pg8::Gemm g{ACT, (const bf16_t*)(ws + WS_WDN + (size_t)(i * 2 + f) * SZ_WDN1), M, D, DFF, DFF, DFF, 0};
                pg8::StaticOrder S; S.init(M, D, F.G, F.bid);
                pg8::EpiRes E{(i == 0 && s == 2) ? (const void*)ap->in[0] : (const void*)XB, (i == 0 && s == 2) ? 1 : 0, XB, mv + (f == 0 ? 2 : 8) * D, nullptr, 0.5f};
                pg8::gemm_phase<pg8::EpiRes, pg8::StaticOrder, true, true>(F.lds, g, S, E); }
            } else if (kind == 0) { if constexpr (ENM & 16) {
                if (s == 4) pooldiff_phase(F, XN, AO);
                else { pg8::Gemm g{AO, (const bf16_t*)(ws + WS_WPOOL), M, D, 256, D, 256, 512};
                    pg8::StaticOrder S; S.init(M, D, F.G, F.bid);
                    pg8::EpiRes E{XB, 0, XB, mv + 5 * D, ap->in[8], 1.0f};
                    pg8::gemm_phase<pg8::EpiRes, pg8::StaticOrder, true, true>(F.lds, g, S, E); }
            } } else if (kind == 1) { if constexpr (ENM & 32) {
                if (s == 4) { pg8::Gemm g{XN, (const bf16_t*)(ws + WS_WDQKV), M, 3072, D, D, D, 0};
                    pg8::StaticOrder S; S.init(M, 3072, F.G, F.bid);
                    pg8::EpiDiffQkv E{ws, (const float*)(ws + WS_ROPE1)};
                    pg8::gemm_phase<pg8::EpiDiffQkv, pg8::StaticOrder, true, true>(F.lds, g, S, E);
                } else if (s == 5) {
                    const float* lm = ap->in[10]; float d01 = 0.f, d23 = 0.f;
                    for (int e = 0; e < 64; ++e) { d01 += lm[e] * lm[64 + e]; d23 += lm[128 + e] * lm[192 + e]; }
                    const float lam = expf(d01) - expf(d23) + LAM_INIT;
                    float* S0 = (float*)(ws + WS_S0) + (size_t)F.bid * 256 * 128;
                    for (int u = F.bid; u < BATCH * 8 * 64; u += F.G) {
                        const int it = u / F.G, xcd = F.bid & 7, idx = F.bid >> 3;
                        const int bh = (F.G == 256) ? it * 4 + (xcd >> 1) : (u >> 6), qb = (F.G == 256) ? (xcd & 1) * 32 + idx : (u & 63), b = bh >> 3, h = bh & 7;
                        const size_t qrow = (size_t)b * SEQ + (size_t)qb * 256, krow = (size_t)b * SEQ;
                        att::EpiArgs ea{AO + qrow * 1024 + h * 128, S0, ap->in[11], lam};
                        att::attn_pp_body<64, 1024, 1024, 1024, 1024, 1>(QB + qrow * 1024 + (2 * h) * 64, KB + krow * 1024 + (2 * h) * 64, VB + krow * 1024 + h * 128, ea, SEQ, (LAS char*)F.lds, (F.bid >> 3) * 2);
                        att::attn_pp_body<64, 1024, 1024, 1024, 1024, 2>(QB + qrow * 1024 + (2 * h + 1) * 64, KB + krow * 1024 + (2 * h + 1) * 64, VB + krow * 1024 + h * 128, ea, SEQ, (LAS char*)F.lds, (F.bid >> 3) * 2);
                    }
                } else { pg8::Gemm g{AO, (const bf16_t*)(ws + WS_WDO), M, D, D, D, D, 0};
                    pg8::StaticOrder S; S.init(M, D, F.G, F.bid);
                    pg8::EpiRes E{XB, 0, XB, mv + 5 * D, nullptr, 1.0f};
                    pg8::gemm_phase<pg8::EpiRes, pg8::StaticOrder, true, true>(F.lds, g, S, E); }
            } } else if (kind == 2) { if constexpr (ENM & 64) {
                if (s == 4) { pg8::Gemm g{XN, (const bf16_t*)(ws + WS_WGQKV), M, 1536, D, D, D, 0};
                    pg8::StaticOrder S; S.init(M, 1536, F.G, F.bid);
                    pg8::EpiGqaQkv E{ws};
                    pg8::gemm_phase<pg8::EpiGqaQkv, pg8::StaticOrder, true, true>(F.lds, g, S, E);
                } else if (s == 5) qknorm_phase(F, QB, KB, ap->in[14], ap->in[15], (const float*)(ws + WS_AXR));
                else if (s == 6) {
                    for (int u = F.bid; u < BATCH * 8 * 64; u += F.G) {
                        const int bh = u >> 6, qb = u & 63, b = bh >> 3, h = bh & 7, kvh = h >> 2;
                        const size_t qrow = (size_t)b * SEQ + (size_t)qb * 256, krow = (size_t)b * SEQ;
                        att::EpiArgs ea{AO + qrow * 1024 + h * 128, nullptr, nullptr, 0.f};
                        att::attn_pp_body<128, 1024, 256, 256, 1024, 0>(QB + qrow * 1024 + h * 128, KB + krow * 256 + kvh * 128, VB + krow * 256 + kvh * 128, ea, SEQ, (LAS char*)F.lds, (F.bid >> 3) * 2);
                    }
                } else { pg8::Gemm g{AO, (const bf16_t*)(ws + WS_WGO), M, D, D, D, D, 0};
                    pg8::StaticOrder S; S.init(M, D, F.G, F.bid);
                    pg8::EpiRes E{XB, 0, XB, mv + 5 * D, nullptr, 1.0f};
                    pg8::gemm_phase<pg8::EpiRes, pg8::StaticOrder, true, true>(F.lds, g, S, E); }
            } } else { if constexpr (ENM & 128) {
                if (s == 4) { pg8::Gemm g{XN, (const bf16_t*)(ws + WS_WCIN), M, 3072, D, D, D, 0};
                    pg8::StaticOrder S; S.init(M, 3072, F.G, F.bid);
                    pg8::EpiConvIn E{QB, KB};
                    pg8::gemm_phase<pg8::EpiConvIn, pg8::StaticOrder, true, true>(F.lds, g, S, E);
                } else if (s == 5) conv_phase(F, QB, KB, ap->in[18], AO);
                else { pg8::Gemm g{AO, (const bf16_t*)(ws + WS_WCOUT), M, D, D, D, D, 0};
                    pg8::StaticOrder S; S.init(M, D, F.G, F.bid);
                    pg8::EpiRes E{XB, 0, XB, mv + 5 * D, nullptr, 1.0f};
                    pg8::gemm_phase<pg8::EpiRes, pg8::StaticOrder, true, true>(F.lds, g, S, E); }
            } }
        }
        bool more = false;
        for (int q = ph + 1; q < ph_hi; ++q) if (phase_active(q)) { more = true; break; }
#if PROBE_DUP
        if (rep == 0 && probe_dup(ph)) { rep = 1; --ph; more = true; } else rep = 0;
#endif
        SEAM(ph, more);
#if PROBE_DUP == 8
        if (ph == 1) { for (int q = 0; q < 40; ++q) { XcdBarrier xb; xb.bar = (unsigned*)(ap->ws + WS_BAR); xb.x = xb_xcc_id(); xb.st = XB_ST(); xcd_barrier(xb); } }
#endif
    }
}

extern "C" void kernel_launch(void* const* d_in, const int* in_sizes, int n_in, void* d_out, int out_size, void* d_ws, size_t ws_size, hipStream_t stream) {
    static int grid = 0;
    if (grid == 0) {
        if (n_in != 21 || in_sizes[0] != M * D || out_size != M * D || ws_size < WS_END) {
            fprintf(stderr, "kernel_launch: shape mismatch n_in %d in0 %d out %d ws %zu (need %zu)\n", n_in, n_in > 0 ? in_sizes[0] : -1, out_size, ws_size, (size_t)WS_END); grid = -1; return; }
        int dev = 0, cus = 0, per_cu = 0;
        (void)hipGetDevice(&dev); (void)hipDeviceGetAttribute(&cus, hipDeviceAttributeMultiprocessorCount, dev);
        if (hipFuncSetAttribute((const void*)fwd_kernel, hipFuncAttributeMaxDynamicSharedMemorySize, LDS_BYTES) != hipSuccess) { fprintf(stderr, "kernel_launch: hipFuncSetAttribute failed\n"); grid = -1; return; }
        if (hipOccupancyMaxActiveBlocksPerMultiprocessor(&per_cu, (const void*)fwd_kernel, NTHR, LDS_BYTES) != hipSuccess || per_cu < 1) { fprintf(stderr, "kernel_launch: occupancy query gave %d\n", per_cu); per_cu = 1; }
        (void)hipGetLastError();
        grid = cus * per_cu;
        fprintf(stderr, "kernel_launch: grid %d (cus %d x %d)\n", grid, cus, per_cu);
    }
    if (grid < 0) return;
    Args a{};
    for (int i = 0; i < 21; ++i) a.in[i] = (const float*)d_in[i];
    a.out = (float*)d_out; a.ws = (unsigned char*)d_ws;
#if MK_ONE_LAUNCH
    a.ph_lo = 0; a.ph_hi = NPH;
    void* args[] = {&a};
    hipError_t e = hipLaunchCooperativeKernel((const void*)fwd_kernel, dim3(grid), dim3(NTHR), args, LDS_BYTES, stream);
    if (e != hipSuccess) fprintf(stderr, "cooperative launch failed: %s (grid %d)\n", hipGetErrorString(e), grid);
#else
    for (int ph = 0; ph < NPH; ++ph) {
        if (!phase_active(ph)) continue;
        a.ph_lo = ph; a.ph_hi = ph + 1;
        hipLaunchKernelGGL(fwd_kernel, dim3(grid), dim3(NTHR), LDS_BYTES, stream, a);
    }
#endif
}
```

```cpp
#include <hip/hip_runtime.h>
#include <hip/hip_bf16.h>
#include <hip/hip_cooperative_groups.h>
#include <cstdio>
#include <cstdint>
namespace cg = cooperative_groups;

#ifndef MK_ONE_LAUNCH
#define MK_ONE_LAUNCH 1
#endif

constexpr int D = 1024, BATCH = 2, SEQ = 16384, M = BATCH * SEQ, DEPTH = 4, DFF = 2816, NMOD = 9;
constexpr float EPS = 1e-6f;
constexpr float LAM_INIT = 0.35550906759096934f;
constexpr int NWAVES = 8, NTHR = 512;

__constant__ float INV1[8] = {1.000000000e+00f, 1.939227581e-01f, 3.760603070e-02f, 7.292665076e-03f, 1.414213446e-03f, 2.742481884e-04f, 5.318296462e-05f, 1.031338525e-05f};
__constant__ float INV2[32] = {1.000000000e+00f, 7.498942018e-01f, 5.623413324e-01f, 4.216965139e-01f, 3.162277639e-01f, 2.371373922e-01f, 1.778279394e-01f, 1.333521456e-01f, 1.000000015e-01f, 7.498941571e-02f, 5.623412877e-02f, 4.216964915e-02f, 3.162277862e-02f, 2.371373586e-02f, 1.778279431e-02f, 1.333521493e-02f, 9.999999776e-03f, 7.498942316e-03f, 5.623413250e-03f, 4.216964822e-03f, 3.162277862e-03f, 2.371373819e-03f, 1.778279431e-03f, 1.333521446e-03f, 1.000000047e-03f, 7.498941850e-04f, 5.623413017e-04f, 4.216965463e-04f, 3.162277862e-04f, 2.371373848e-04f, 1.778279402e-04f, 1.333521504e-04f};

constexpr size_t MiB = 1u << 20;
constexpr size_t WS_MODV  = 0;
constexpr size_t WS_ROPE1 = 1 * MiB;
constexpr size_t WS_AXR   = 2 * MiB;
constexpr size_t WS_AXC   = 2 * MiB + 65536;
constexpr size_t WS_BAR   = 3 * MiB;
constexpr size_t WS_WGU   = 4 * MiB;
constexpr size_t SZ_WGU1  = (size_t)2 * DFF * D * 2;
constexpr size_t WS_WDN   = WS_WGU + 8 * SZ_WGU1;
constexpr size_t SZ_WDN1  = (size_t)D * DFF * 2;
constexpr size_t WS_WPOOL = WS_WDN + 8 * SZ_WDN1;
constexpr size_t WS_WDQKV = WS_WPOOL + (size_t)1024 * 256 * 2;
constexpr size_t WS_WDO   = WS_WDQKV + (size_t)3072 * 1024 * 2;
constexpr size_t WS_WGQKV = WS_WDO + (size_t)1024 * 1024 * 2;
constexpr size_t WS_WGO   = WS_WGQKV + (size_t)1536 * 1024 * 2;
constexpr size_t WS_WCIN  = WS_WGO + (size_t)1024 * 1024 * 2;
constexpr size_t WS_WCOUT = WS_WCIN + (size_t)3072 * 1024 * 2;
constexpr size_t WS_XN    = ((WS_WCOUT + (size_t)1024 * 1024 * 2 + MiB - 1) / MiB) * MiB;
constexpr size_t SZ_ACT1K = (size_t)M * D * 2;
constexpr size_t WS_ACT   = WS_XN + SZ_ACT1K;
constexpr size_t WS_Q     = WS_ACT, WS_K = WS_ACT + SZ_ACT1K;
constexpr size_t WS_V     = WS_ACT + (size_t)M * DFF * 2;
constexpr size_t WS_AO    = WS_V + SZ_ACT1K;
constexpr size_t WS_S0    = WS_AO + SZ_ACT1K;
constexpr size_t WS_XB    = WS_S0 + (size_t)256 * 256 * 128 * 4;
constexpr size_t WS_END   = WS_XB + SZ_ACT1K;

struct Args { const float* in[21]; float* out; unsigned char* ws; int ph_lo, ph_hi; };
typedef const __attribute__((address_space(4))) Args* KArgs;

#define LAS __attribute__((address_space(3)))
typedef unsigned short bf16_t;
typedef unsigned v4u __attribute__((ext_vector_type(4)));
typedef unsigned v2u __attribute__((ext_vector_type(2)));
typedef float f32x4 __attribute__((ext_vector_type(4)));
typedef float f32x2 __attribute__((ext_vector_type(2)));
#define LDS_WAIT() asm volatile("s_waitcnt lgkmcnt(0)" ::: "memory")
__device__ __forceinline__ unsigned cvt_pk_bf16(float lo, float hi) { unsigned r; asm volatile("v_cvt_pk_bf16_f32 %0, %1, %2" : "=v"(r) : "v"(lo), "v"(hi)); return r; }
typedef _Float16 h16x4 __attribute__((ext_vector_type(4)));
typedef _Float16 h16x8 __attribute__((ext_vector_type(8)));
typedef float f32x8 __attribute__((ext_vector_type(8)));
__device__ __forceinline__ f32x4 half4_to_f32(v2u w) { return __builtin_convertvector(__builtin_bit_cast(h16x4, w), f32x4); }
__device__ __forceinline__ v2u f32_to_half4(f32x4 v) { return __builtin_bit_cast(v2u, __builtin_convertvector(v, h16x4)); }
__device__ __forceinline__ float bf_lo(unsigned w) { return __uint_as_float(w << 16); }
__device__ __forceinline__ float bf_hi(unsigned w) { return __uint_as_float(w & 0xffff0000u); }
__device__ __forceinline__ float wave_sum(float v) {
#pragma unroll
    for (int o = 1; o < 64; o <<= 1) v += __shfl_xor(v, o);
    return v;
}
__device__ __forceinline__ float silu_f(float g) { return g * __builtin_amdgcn_rcpf(1.0f + __builtin_amdgcn_exp2f(-1.4426950408889634f * g)); }
__device__ __forceinline__ void sincos_acc(float angf, float& c, float& s) {
    const double x = (double)angf;
    const double k = __builtin_rint(x * 0.63661977236758134308);
    double y = __builtin_fma(-k, 1.57079632679489655800, x); y = __builtin_fma(-k, 6.12323399573676603587e-17, y);
    const int q = (int)((long long)k & 3LL);
    const double y2 = y * y;
    const double sp = y * (1.0 + y2 * (-1.0 / 6 + y2 * (1.0 / 120 + y2 * (-1.0 / 5040 + y2 * (1.0 / 362880 + y2 * (-1.0 / 39916800 + y2 * (1.0 / 6227020800.0)))))));
    const double cp = 1.0 + y2 * (-0.5 + y2 * (1.0 / 24 + y2 * (-1.0 / 720 + y2 * (1.0 / 40320 + y2 * (-1.0 / 3628800 + y2 * (1.0 / 479001600.0 + y2 * (-1.0 / 87178291200.0)))))));
    const double ss = (q == 0) ? sp : (q == 1) ? cp : (q == 2) ? -sp : -cp;
    const double cc = (q == 0) ? cp : (q == 1) ? -sp : (q == 2) ? -cp : sp;
    c = (float)cc; s = (float)ss;
}


namespace pg8 {
#define PG8_LAS __attribute__((address_space(3)))
typedef unsigned short bf16_t;
typedef short bf16x8 __attribute__((ext_vector_type(8)));
typedef float f32x4 __attribute__((ext_vector_type(4)));
typedef unsigned u32x4 __attribute__((ext_vector_type(4)));
constexpr int BM = 256, BK = 64, HALF = 128, HTB = HALF * BK * 2  , STAGE_BYTES = 8 * HTB, NXCD = 8, WGM = 8;

__host__ __device__ __forceinline__ int lds_byte(int r, int c) { const int st = (r >> 4) * 2 + (c >> 5), rr = r & 15, cc = c & 31, ob = rr * 64 + cc * 2; return st * 1024 + (ob ^ (((ob >> 9) & 1) << 5)); }
__host__ __device__ __forceinline__ void stage_rc(int b, int& R, int& C) { const int st = b / 1024, sb = b % 1024, swz = sb ^ (((sb >> 9) & 1) << 5); R = (st >> 1) * 16 + swz / 64; C = (st & 1) * 32 + (swz % 64) / 2; }
__host__ __device__ __forceinline__ int perm32(int rho) { const int n = rho >> 4, i = rho & 15; return 8 * (i >> 2) + 4 * n + (i & 3); }

struct Unit { int pm, pn; };
struct Gemm { const bf16_t* A; const bf16_t* Bt; int M, N, K, lda, ldb, acolb; };

struct StaticOrder {
    int nM, nN, nwg, G, c;
    __host__ __device__ void init(int M, int N, int G_, int c_) { nM = M / BM; nN = N / BM; nwg = nM * nN; G = G_; c = c_; }
    __host__ __device__ bool next(int i, Unit& u) const {
        const long L = (long)i * G + c; if (L >= nwg) return false;
        int wgid = (int)L; { const int q = nwg / NXCD, r = nwg % NXCD, xcd = wgid % NXCD, off = wgid / NXCD; wgid = (xcd < r ? xcd * (q + 1) : r * (q + 1) + (xcd - r) * q) + off; }
        const int nig = WGM * nN, gid = wgid / nig, fm = gid * WGM, gsz = (nM - fm) < WGM ? (nM - fm) : WGM;
        u.pm = fm + ((wgid % nig) % gsz); u.pn = (wgid % nig) / gsz; return true;
    }
    __device__ __forceinline__ void a_ready(const Unit&) const {}
    __device__ __forceinline__ void done(const Unit&) const {}
};

__device__ __forceinline__ unsigned cvt_pk_bf16(float lo, float hi) { unsigned r; asm volatile("v_cvt_pk_bf16_f32 %0, %1, %2" : "=v"(r) : "v"(lo), "v"(hi)); return r; }
__device__ __forceinline__ float silu_f(float g) { return g * __builtin_amdgcn_rcpf(1.0f + __builtin_amdgcn_exp2f(-1.4426950408889634f * g)); }
__device__ __forceinline__ u32x4 pack8(const f32x4 v0, const f32x4 v1) { u32x4 w; w.x = cvt_pk_bf16(v0[0], v0[1]); w.y = cvt_pk_bf16(v0[2], v0[3]); w.z = cvt_pk_bf16(v1[0], v1[1]); w.w = cvt_pk_bf16(v1[2], v1[3]); return w; }

typedef _Float16 h16x8 __attribute__((ext_vector_type(8))); typedef float f32x8 __attribute__((ext_vector_type(8)));
__device__ __forceinline__ void unpack8(const u32x4 w, f32x4& a, f32x4& b) { const f32x8 f = __builtin_convertvector(__builtin_bit_cast(h16x8, w), f32x8);
    a = (f32x4){f[0], f[1], f[2], f[3]}; b = (f32x4){f[4], f[5], f[6], f[7]}; }
__device__ __forceinline__ u32x4 pack8h(const f32x4 a, const f32x4 b) { const f32x8 f = {a[0], a[1], a[2], a[3], b[0], b[1], b[2], b[3]}; return __builtin_bit_cast(u32x4, __builtin_convertvector(f, h16x8)); }
struct EpiRes {
    static constexpr bool PERM = true, AFTER_DRAIN = false;
    const void* xin; int xin_f32; bf16_t* xout; const float* gate; const float* cscale; float mul;
    __device__ __forceinline__ void operator()(const f32x4 (&acc)[2][2][4][2], const Unit& u, int wr, int wc, int fr, int fq) const {
        const int b = u.pm >> 6;
        const float* gb = gate + (size_t)b * 9216;
        const int col0 = u.pn * BM + wc * 32 + 8 * fq;
        f32x4 gv[2][2];
#pragma unroll
        for (int bj = 0; bj < 2; ++bj)
#pragma unroll
            for (int n = 0; n < 2; ++n) { f32x4 g = *(const f32x4*)(gb + col0 + bj * HALF + 4 * n) * mul;
                if (cscale) g = g * *(const f32x4*)(cscale + col0 + bj * HALF + 4 * n); gv[bj][n] = g; }
#pragma unroll
        for (int ai = 0; ai < 2; ++ai)
#pragma unroll
            for (int m = 0; m < 4; ++m) { const size_t off = (size_t)(u.pm * BM + ai * HALF + wr * 64 + m * 16 + fr) * 1024 + col0;
#pragma unroll
                for (int bj = 0; bj < 2; ++bj) { f32x4 x0, x1;
                    if (xin_f32) { const float* p = (const float*)xin + off + bj * HALF; x0 = *(const f32x4*)p; x1 = *(const f32x4*)(p + 4); }
                    else unpack8(*(const u32x4*)((const bf16_t*)xin + off + bj * HALF), x0, x1);
                    *(u32x4*)(xout + off + bj * HALF) = pack8h(x0 + gv[bj][0] * acc[ai][bj][m][0], x1 + gv[bj][1] * acc[ai][bj][m][1]); }
                if (m & 1) asm volatile("" ::: "memory"); }
    }
};
struct EpiSwiglu {
    static constexpr bool PERM = true, AFTER_DRAIN = false;
    bf16_t* O; int ldc;
    __device__ __forceinline__ void operator()(const f32x4 (&acc)[2][2][4][2], const Unit& u, int wr, int wc, int fr, int fq) const {
        const int col0 = u.pn * HALF + wc * 32 + 8 * fq;
#pragma unroll
        for (int ai = 0; ai < 2; ++ai)
#pragma unroll
            for (int m = 0; m < 4; ++m) { bf16_t* p = O + (size_t)(u.pm * BM + ai * HALF + wr * 64 + m * 16 + fr) * ldc + col0;
                f32x4 v0, v1;
#pragma unroll
                for (int e = 0; e < 4; ++e) { v0[e] = silu_f(acc[ai][0][m][0][e]) * acc[ai][1][m][0][e]; v1[e] = silu_f(acc[ai][0][m][1][e]) * acc[ai][1][m][1][e]; }
                *(u32x4*)p = pack8(v0, v1); }
    }
};
struct EpiConvIn {
    static constexpr bool PERM = true, AFTER_DRAIN = false;
    bf16_t* Z; bf16_t* GB;
    __device__ __forceinline__ void operator()(const f32x4 (&acc)[2][2][4][2], const Unit& u, int wr, int wc, int fr, int fq) const {
        if (u.pn < 8) {
            const int col0 = u.pn * HALF + wc * 32 + 8 * fq;
#pragma unroll
            for (int ai = 0; ai < 2; ++ai)
#pragma unroll
                for (int m = 0; m < 4; ++m) { bf16_t* p = Z + (size_t)(u.pm * BM + ai * HALF + wr * 64 + m * 16 + fr) * 1024 + col0;
                    *(u32x4*)p = pack8(acc[ai][0][m][0] * acc[ai][1][m][0], acc[ai][0][m][1] * acc[ai][1][m][1]); }
        } else {
            const int col0 = (u.pn - 8) * BM + wc * 32 + 8 * fq;
#pragma unroll
            for (int ai = 0; ai < 2; ++ai)
#pragma unroll
                for (int m = 0; m < 4; ++m) { bf16_t* p = GB + (size_t)(u.pm * BM + ai * HALF + wr * 64 + m * 16 + fr) * 1024 + col0;
#pragma unroll
                    for (int bj = 0; bj < 2; ++bj) *(u32x4*)(p + bj * HALF) = pack8(acc[ai][bj][m][0], acc[ai][bj][m][1]); }
        }
    }
};
struct EpiGqaQkv {
    static constexpr bool PERM = true, AFTER_DRAIN = false;
    unsigned char* ws;
    __device__ __forceinline__ void operator()(const f32x4 (&acc)[2][2][4][2], const Unit& u, int wr, int wc, int fr, int fq) const {
        const size_t boff = u.pn < 4 ? WS_Q : (u.pn == 4 ? WS_K : WS_V); bf16_t* base = (bf16_t*)(ws + boff); const int ld = u.pn < 4 ? 1024 : 256; const int colt = u.pn < 4 ? u.pn * BM : 0;
        const int col0 = colt + wc * 32 + 8 * fq;
#pragma unroll
        for (int ai = 0; ai < 2; ++ai)
#pragma unroll
            for (int m = 0; m < 4; ++m) { bf16_t* p = base + (size_t)(u.pm * BM + ai * HALF + wr * 64 + m * 16 + fr) * ld + col0;
#pragma unroll
                for (int bj = 0; bj < 2; ++bj) *(u32x4*)(p + bj * HALF) = pack8(acc[ai][bj][m][0], acc[ai][bj][m][1]); }
    }
};
struct EpiDiffQkv {
    static constexpr bool PERM = true, AFTER_DRAIN = false;
    unsigned char* ws; const float* rope;
    __device__ __forceinline__ void operator()(const f32x4 (&acc)[2][2][4][2], const Unit& u, int wr, int wc, int fr, int fq) const {
        const int t = u.pn >> 2; const size_t boff = t == 0 ? WS_Q : (t == 1 ? WS_K : WS_V); bf16_t* base = (bf16_t*)(ws + boff);
        const int col0 = (u.pn & 3) * BM + wc * 32 + 8 * fq;
        const bool rot = ((wc & 1) == 0) && (fq < 2);
#pragma unroll
        for (int ai = 0; ai < 2; ++ai)
#pragma unroll
            for (int m = 0; m < 4; ++m) { const int row = u.pm * BM + ai * HALF + wr * 64 + m * 16 + fr; bf16_t* p = base + (size_t)row * 1024 + col0;
                f32x4 cs0 = {1.f, 1.f, 1.f, 1.f}, cs1 = cs0, sn0 = {0.f, 0.f, 0.f, 0.f}, sn1 = sn0;
                if (t < 2 && rot) { const float* rp = rope + (size_t)(row & (SEQ - 1)) * 16; cs0 = *(const f32x4*)rp; cs1 = *(const f32x4*)(rp + 4); sn0 = *(const f32x4*)(rp + 8); sn1 = *(const f32x4*)(rp + 12);
                    if (fq == 0) { sn0 = -sn0; sn1 = -sn1; } }
#pragma unroll
                for (int bj = 0; bj < 2; ++bj) { f32x4 v0 = acc[ai][bj][m][0], v1 = acc[ai][bj][m][1];
                    if (t < 2) { f32x4 p0, p1;
#pragma unroll
                        for (int e = 0; e < 4; ++e) { p0[e] = __shfl_xor(v0[e], 16); p1[e] = __shfl_xor(v1[e], 16); }
                        v0 = v0 * cs0 + p0 * sn0; v1 = v1 * cs1 + p1 * sn1;
                        if (t == 0) { v0 = v0 * 0.18033688011112042f; v1 = v1 * 0.18033688011112042f; } }
                    *(u32x4*)(p + bj * HALF) = pack8(v0, v1); } }
    }
};

template <class Epi, class Sched, bool ALIGN_EPI = false, bool SP2 = false>
__device__ __forceinline__ void gemm_phase(PG8_LAS unsigned char* lds, const Gemm g, const Sched& S, const Epi& E) {
    int tid_ = threadIdx.x; asm volatile("" : "+v"(tid_)); const int tid = tid_, wid = __builtin_amdgcn_readfirstlane(tid >> 6), lane = tid & 63, wr = wid >> 2, wc = wid & 3, fr = lane & 15, fq = lane >> 4;
    const int K = g.K, nt = K / BK;
    unsigned voffA[2], voffB[2];
#pragma unroll
    for (int i = 0; i < 2; ++i) { int R, C; stage_rc(tid * 16 + i * 8192, R, C); const int Rb = Epi::PERM ? ((R & ~31) + perm32(R & 31)) : R;
        voffA[i] = (unsigned)(R * g.lda + C) * 2u; voffB[i] = (unsigned)(Rb * g.ldb + C) * 2u; }
    const size_t kstep = (size_t)(BK * 2);
    const size_t hstepA = (size_t)HALF * g.lda * 2, hstepB = (size_t)HALF * g.ldb * 2;
    const size_t tstepA = 2 * hstepA, tstepB = 2 * hstepB;
    const unsigned ldsw = (unsigned)wid * 1024u;
    const int aoff = lds_byte(wr * 64 + fr, fq * 8), boff = lds_byte(wc * 32 + fr, fq * 8);
#define PG8_SA(b, h) (((b) * 2 + (h)) * HTB)
#define PG8_SB(b, h) ((4 + (b) * 2 + (h)) * HTB)
#define PG8_STAGE(bufoff, gbase, voff) do { _Pragma("unroll") for (int _i = 0; _i < 2; ++_i) \
        __builtin_amdgcn_global_load_lds((const unsigned*)((const char*)(gbase) + (voff)[_i]), (PG8_LAS unsigned*)(lds + (bufoff) + ldsw + _i * 8192), 16, 0, 0); } while (0)
#define PG8_LDA(dst, b, h) do { _Pragma("unroll") for (int m = 0; m < 4; ++m) _Pragma("unroll") for (int k = 0; k < 2; ++k) dst[m][k] = *(const PG8_LAS bf16x8*)(lds + PG8_SA(b, h) + aoff + m * 2048 + k * 1024); } while (0)
#define PG8_LDB(dst, b, h) do { _Pragma("unroll") for (int n = 0; n < 2; ++n) _Pragma("unroll") for (int k = 0; k < 2; ++k) dst[n][k] = *(const PG8_LAS bf16x8*)(lds + PG8_SB(b, h) + boff + n * 2048 + k * 1024); } while (0)
#define PG8_MMA(ai, bj, At, Bt) do { __builtin_amdgcn_s_setprio(1); _Pragma("unroll") for (int m = 0; m < 4; ++m) _Pragma("unroll") for (int n = 0; n < 2; ++n) _Pragma("unroll") for (int k = 0; k < 2; ++k) \
        acc[ai][bj][m][n] = __builtin_amdgcn_mfma_f32_16x16x32_bf16(Bt[n][k], At[m][k], acc[ai][bj][m][n], 0, 0, 0); __builtin_amdgcn_s_setprio(0); } while (0)
#define PG8_WAIT_V(n) asm volatile("s_waitcnt vmcnt(" #n ")" ::: "memory")
#define PG8_WAIT_L(n) asm volatile("s_waitcnt lgkmcnt(" #n ")" ::: "memory")
#define PG8_BAR __builtin_amdgcn_s_barrier()
#define PG8_SCHED __builtin_amdgcn_sched_barrier(0)
    Unit cur, nxt; int ui = 0;
    if (!S.next(0, cur)) return;
    f32x4 acc[2][2][4][2];
#pragma unroll
    for (int a = 0; a < 2; ++a)
#pragma unroll
        for (int b = 0; b < 2; ++b)
#pragma unroll
            for (int m = 0; m < 4; ++m)
#pragma unroll
                for (int n = 0; n < 2; ++n) acc[a][b][m][n] = (f32x4){0.f, 0.f, 0.f, 0.f};
    bf16x8 At[4][2], B0[2][2], B1[2][2];
    const char* cA = (const char*)g.A + (size_t)cur.pm * tstepA + (size_t)cur.pn * g.acolb; const char* cB = (const char*)g.Bt + (size_t)cur.pn * tstepB;
    S.a_ready(cur);
    if constexpr (SP2) {
        PG8_STAGE(PG8_SB(0, 0), cB, voffB); PG8_STAGE(PG8_SB(0, 1), cB + hstepB, voffB); PG8_STAGE(PG8_SA(0, 0), cA, voffA); PG8_STAGE(PG8_SA(0, 1), cA + hstepA, voffA);
        if (wr == 1) PG8_BAR;
        PG8_WAIT_V(2); PG8_BAR;
        PG8_STAGE(PG8_SB(1, 0), cB + kstep, voffB); PG8_STAGE(PG8_SA(1, 0), cA + kstep, voffA); PG8_STAGE(PG8_SB(1, 1), cB + hstepB + kstep, voffB);
        PG8_WAIT_V(6); PG8_BAR;
    } else {
        PG8_STAGE(PG8_SB(0, 0), cB, voffB); PG8_STAGE(PG8_SA(0, 0), cA, voffA); PG8_STAGE(PG8_SB(0, 1), cB + hstepB, voffB); PG8_STAGE(PG8_SA(0, 1), cA + hstepA, voffA);
        if (wr == 1) PG8_BAR;
        PG8_WAIT_V(4); PG8_BAR;
        PG8_STAGE(PG8_SB(1, 0), cB + kstep, voffB); PG8_STAGE(PG8_SA(1, 0), cA + kstep, voffA); PG8_STAGE(PG8_SB(1, 1), cB + hstepB + kstep, voffB);
        PG8_WAIT_V(6); PG8_BAR;
    }
    for (;;) {
        const bool has_next = S.next(ui + 1, nxt);
        const char* nA = has_next ? (const char*)g.A + (size_t)nxt.pm * tstepA + (size_t)nxt.pn * g.acolb : cA; const char* nB = has_next ? (const char*)g.Bt + (size_t)nxt.pn * tstepB : cB;
        for (int t = 0; t < nt; t += 2) {
            const bool last = (t == nt - 2);
            const char* a1 = cA + (size_t)(t + 1) * kstep;
            const char* a2 = last ? nA : cA + (size_t)(t + 2) * kstep; const char* b2 = last ? nB : cB + (size_t)(t + 2) * kstep;
            const char* a3 = a2 + kstep; const char* b3 = b2 + kstep;
            if (last && has_next) S.a_ready(nxt);
            if constexpr (SP2) {
            PG8_LDB(B0, 0, 0); PG8_LDB(B1, 0, 1); PG8_SCHED; PG8_LDA(At, 0, 0); PG8_STAGE(PG8_SA(1, 1), a1 + hstepA, voffA);
            PG8_WAIT_V(8); PG8_WAIT_L(0); PG8_BAR; PG8_MMA(0, 0, At, B0); PG8_MMA(0, 1, At, B1); PG8_BAR; PG8_SCHED;
            PG8_LDA(At, 0, 1); PG8_STAGE(PG8_SB(0, 0), b2, voffB); PG8_STAGE(PG8_SB(0, 1), b2 + hstepB, voffB); PG8_STAGE(PG8_SA(0, 0), a2, voffA);
            PG8_WAIT_V(8); PG8_WAIT_L(0); PG8_BAR; PG8_MMA(1, 0, At, B0); PG8_MMA(1, 1, At, B1); PG8_BAR; PG8_SCHED;
            PG8_LDB(B0, 1, 0); PG8_LDB(B1, 1, 1); PG8_SCHED; PG8_LDA(At, 1, 0); PG8_STAGE(PG8_SA(0, 1), a2 + hstepA, voffA);
            PG8_WAIT_V(8); PG8_WAIT_L(0); PG8_BAR; PG8_MMA(0, 0, At, B0); PG8_MMA(0, 1, At, B1); PG8_BAR; PG8_SCHED;
            PG8_LDA(At, 1, 1); PG8_STAGE(PG8_SB(1, 0), b3, voffB); PG8_STAGE(PG8_SB(1, 1), b3 + hstepB, voffB); PG8_STAGE(PG8_SA(1, 0), a3, voffA);
            PG8_WAIT_V(8); PG8_WAIT_L(0); PG8_BAR; PG8_MMA(1, 0, At, B0); PG8_MMA(1, 1, At, B1); PG8_BAR; PG8_SCHED;
            } else {
            PG8_LDB(B0, 0, 0); PG8_SCHED; PG8_LDA(At, 0, 0); PG8_STAGE(PG8_SA(1, 1), a1 + hstepA, voffA);
            PG8_WAIT_L(8); PG8_BAR; PG8_WAIT_L(0); PG8_MMA(0, 0, At, B0); PG8_BAR; PG8_SCHED;
            PG8_LDB(B1, 0, 1); PG8_STAGE(PG8_SB(0, 0), b2, voffB);
            PG8_BAR; PG8_WAIT_L(0); PG8_MMA(0, 1, At, B1); PG8_BAR;
            PG8_LDA(At, 0, 1); PG8_STAGE(PG8_SA(0, 0), a2, voffA);
            PG8_BAR; PG8_WAIT_L(0); PG8_MMA(1, 0, At, B0); PG8_BAR; PG8_SCHED;
            PG8_STAGE(PG8_SB(0, 1), b2 + hstepB, voffB);
            PG8_WAIT_V(6); PG8_BAR; PG8_MMA(1, 1, At, B1); PG8_BAR;
            PG8_LDB(B0, 1, 0); PG8_SCHED; PG8_LDA(At, 1, 0); PG8_STAGE(PG8_SA(0, 1), a2 + hstepA, voffA);
            PG8_WAIT_L(8); PG8_BAR; PG8_WAIT_L(0); PG8_MMA(0, 0, At, B0); PG8_BAR; PG8_SCHED;
            PG8_LDB(B1, 1, 1); PG8_STAGE(PG8_SB(1, 0), b3, voffB);
            PG8_BAR; PG8_WAIT_L(0); PG8_MMA(0, 1, At, B1); PG8_BAR;
            PG8_LDA(At, 1, 1); PG8_STAGE(PG8_SA(1, 0), a3, voffA);
            PG8_BAR; PG8_WAIT_L(0); PG8_MMA(1, 0, At, B0); PG8_BAR; PG8_SCHED;
            PG8_STAGE(PG8_SB(1, 1), b3 + hstepB, voffB);
            PG8_WAIT_V(6); PG8_BAR; PG8_MMA(1, 1, At, B1); PG8_BAR;
            }
        }
        if constexpr (ALIGN_EPI) { if (wr == 0) PG8_BAR; }
        if constexpr (!Epi::AFTER_DRAIN) { E(acc, cur, wr, wc, fr, fq); S.done(cur); }
        if (!has_next) break;
#pragma unroll
        for (int a = 0; a < 2; ++a)
#pragma unroll
            for (int b = 0; b < 2; ++b)
#pragma unroll
                for (int m = 0; m < 4; ++m)
#pragma unroll
                    for (int n = 0; n < 2; ++n) acc[a][b][m][n] = (f32x4){0.f, 0.f, 0.f, 0.f};
        cur = nxt; cA = nA; cB = nB; ++ui;
        if constexpr (ALIGN_EPI) { if (wr == 1) PG8_BAR; }
    }
    PG8_WAIT_V(0);
    if constexpr (!ALIGN_EPI) { if (wr == 0) PG8_BAR; }
    PG8_BAR;
    if constexpr (Epi::AFTER_DRAIN) { E.fused(acc, cur, wr, wc, fr, fq, lds, wid, lane); S.done(cur); }
#undef PG8_SA
#undef PG8_SB
#undef PG8_STAGE
#undef PG8_LDA
#undef PG8_LDB
#undef PG8_MMA
#undef PG8_WAIT_V
#undef PG8_WAIT_L
#undef PG8_BAR
#undef PG8_SCHED
}
}

namespace att {
using bf16x8 = __attribute__((ext_vector_type(8))) short;
using s16x4  = __attribute__((ext_vector_type(4))) short;
using f32x16 = __attribute__((ext_vector_type(16))) float;
using u32x4  = __attribute__((ext_vector_type(4))) unsigned;
constexpr int NW = 8, QBLK = 32, KVBLK = 64, DV = 128;
constexpr float THRN = 8.f;
constexpr size_t SHM_V = KVBLK * DV * 2, SHM_KMAX = KVBLK * 128 * 2, SHM_ATTN = 2 * SHM_V + 2 * SHM_KMAX + NW * 64 * 4;
#define SBAR() __builtin_amdgcn_sched_barrier(0)
template <int DQK> __device__ __forceinline__ int kswz(int row, int colB) { if constexpr (DQK == 128) return row * 256 + (colB ^ ((row & 15) << 4)); else return row * 128 + (colB ^ (((row >> 1) & 7) << 4)); }
__device__ __forceinline__ int crow(int r, int hi) { return (r & 3) + 8 * (r >> 2) + 4 * hi; }
typedef float f32x2_t __attribute__((ext_vector_type(2))); typedef __bf16 bf16x2_t __attribute__((ext_vector_type(2)));
__device__ __forceinline__ unsigned cvtpk(float lo, float hi) { const f32x2_t v = {lo, hi}; const bf16x2_t b = __builtin_convertvector(v, bf16x2_t); return __builtin_bit_cast(unsigned, b); }

template <int DQK> __device__ __forceinline__ void partialSM(f32x16& p0, f32x16& p1, float& m_reg, float& mn, float& alpha) {
  constexpr float SCALE = DQK == 128 ? 0.088388347648318440f : 0.125f;
  constexpr float C = SCALE * 1.4426950408889634f;
  float pmax = p0[0];
#pragma unroll
  for (int r = 1; r < 16; ++r) pmax = fmaxf(pmax, p0[r]);
#pragma unroll
  for (int r = 0; r < 16; ++r) pmax = fmaxf(pmax, p1[r]);
  { auto rr = __builtin_amdgcn_permlane32_swap(__float_as_uint(pmax), __float_as_uint(pmax), false, false);
    pmax = fmaxf(__uint_as_float(rr[0]), __uint_as_float(rr[1])); }
  if (__builtin_expect(__all(pmax - m_reg <= THRN / SCALE), 1)) { mn = m_reg; alpha = 1.f; }
  else { mn = fmaxf(m_reg, pmax); alpha = __builtin_amdgcn_exp2f((m_reg - mn) * C); m_reg = mn; }
  float mnC = -mn * C;
#pragma unroll
  for (int r = 0; r < 16; ++r) p0[r] = fmaf(p0[r], C, mnC);
#pragma unroll
  for (int r = 0; r < 16; ++r) p1[r] = fmaf(p1[r], C, mnC);
#pragma unroll
  for (int r = 0; r < 16; ++r) p0[r] = __builtin_amdgcn_exp2f(p0[r]);
}
__device__ __forceinline__ void finishSM(f32x16& p0, f32x16& p1, float alpha, float& l_reg, bf16x8& pa0, bf16x8& pa1, bf16x8& pa2, bf16x8& pa3) {
#pragma unroll
  for (int r = 0; r < 16; ++r) p1[r] = __builtin_amdgcn_exp2f(p1[r]);
  float ps = 0;
#pragma unroll
  for (int r = 0; r < 16; ++r) ps += p0[r];
#pragma unroll
  for (int r = 0; r < 16; ++r) ps += p1[r];
  { auto rr = __builtin_amdgcn_permlane32_swap(__float_as_uint(ps), __float_as_uint(ps), false, false);
    ps = __uint_as_float(rr[0]) + __uint_as_float(rr[1]); }
  l_reg = l_reg * alpha + ps;
#define PK4(P, BASE, OUT) do { unsigned a0 = cvtpk(P[BASE + 0], P[BASE + 1]), a1 = cvtpk(P[BASE + 2], P[BASE + 3]);   \
    unsigned b0 = cvtpk(P[BASE + 4], P[BASE + 5]), b1 = cvtpk(P[BASE + 6], P[BASE + 7]);                              \
    auto r0 = __builtin_amdgcn_permlane32_swap(a0, b0, false, false); auto r1 = __builtin_amdgcn_permlane32_swap(a1, b1, false, false); \
    u32x4 w = {r0[0], r1[0], r0[1], r1[1]}; OUT = *reinterpret_cast<bf16x8*>(&w); } while (0)
  PK4(p0, 0, pa0); PK4(p0, 8, pa1); PK4(p1, 0, pa2); PK4(p1, 8, pa3);
#undef PK4
}
template <int DQK> __device__ __forceinline__ void qkt(f32x16& p0, f32x16& p1, const char* Ks, const bf16x8* qr, int r32, int hi) {
  p0 = f32x16{}; p1 = f32x16{};
#pragma unroll
  for (int d0 = 0; d0 < DQK / 16; ++d0) { int cb = (d0 * 16 + hi * 8) * 2;
    bf16x8 b0 = *reinterpret_cast<const bf16x8*>(Ks + kswz<DQK>(r32, cb));
    bf16x8 b1 = *reinterpret_cast<const bf16x8*>(Ks + kswz<DQK>(32 + r32, cb));
    p0 = __builtin_amdgcn_mfma_f32_32x32x16_bf16(b0, qr[d0], p0, 0, 0, 0);
    p1 = __builtin_amdgcn_mfma_f32_32x32x16_bf16(b1, qr[d0], p1, 0, 0, 0); }
}
__device__ __forceinline__ int v_st(int k, int c) { const int kk = (k & ~0xC) | ((k & 4) << 1) | ((k & 8) >> 1); return ((kk >> 3) * 4 + (c >> 5)) * 512 + ((kk & 7) * 32 + (c & 31)) * 2; }
__device__ __forceinline__ int v_rd_base(int lane) { return ((lane & 3) << 3) | (((lane >> 2) & 3) << 6) | (((lane >> 4) & 1) << 5) | (((lane >> 5) & 1) << 8); }
constexpr int v_rd_off(int d0, int ks, int half) { return d0 * 512 + ks * 4096 + half * 2048; }
template <int OFF> __device__ __forceinline__ s16x4 tr_read(int vb) {
  s16x4 r; asm volatile("ds_read_b64_tr_b16 %0, %1 offset:%2" : "=&v"(r) : "v"(vb), "i"(OFF) : "memory"); return r;
}
template <int D0> __device__ __forceinline__ void pv_one(f32x16& od, int vb, bf16x8 pa0, bf16x8 pa1, bf16x8 pa2, bf16x8 pa3) {
  const s16x4 l0 = tr_read<v_rd_off(D0, 0, 0)>(vb), h0 = tr_read<v_rd_off(D0, 0, 1)>(vb), l1 = tr_read<v_rd_off(D0, 1, 0)>(vb), h1 = tr_read<v_rd_off(D0, 1, 1)>(vb);
  const s16x4 l2 = tr_read<v_rd_off(D0, 2, 0)>(vb), h2 = tr_read<v_rd_off(D0, 2, 1)>(vb), l3 = tr_read<v_rd_off(D0, 3, 0)>(vb), h3 = tr_read<v_rd_off(D0, 3, 1)>(vb);
  asm volatile("s_waitcnt lgkmcnt(0)" ::: "memory"); SBAR();
#define PK(L, H) (bf16x8){L[0], L[1], L[2], L[3], H[0], H[1], H[2], H[3]}
  od = __builtin_amdgcn_mfma_f32_32x32x16_bf16(pa0, PK(l0, h0), od, 0, 0, 0);
  od = __builtin_amdgcn_mfma_f32_32x32x16_bf16(pa1, PK(l1, h1), od, 0, 0, 0);
  od = __builtin_amdgcn_mfma_f32_32x32x16_bf16(pa2, PK(l2, h2), od, 0, 0, 0);
  od = __builtin_amdgcn_mfma_f32_32x32x16_bf16(pa3, PK(l3, h3), od, 0, 0, 0);
#undef PK
}
__device__ __forceinline__ void pv_d0(f32x16* o, int vb, bf16x8 pa0, bf16x8 pa1, bf16x8 pa2, bf16x8 pa3) {
  pv_one<0>(o[0], vb, pa0, pa1, pa2, pa3); pv_one<1>(o[1], vb, pa0, pa1, pa2, pa3); pv_one<2>(o[2], vb, pa0, pa1, pa2, pa3); pv_one<3>(o[3], vb, pa0, pa1, pa2, pa3);
}

struct EpiArgs { bf16_t* O; float* S0; const float* g; float lam; };

template <int DQK, int LDQ, int LDK, int LDV, int LDO, int MODE>
__device__ __forceinline__ void attn_dense_body(const bf16_t* __restrict__ Qb, const bf16_t* __restrict__ Kh, const bf16_t* __restrict__ Vh, const EpiArgs ea, int seq, char* lds) {
  constexpr size_t SHM_K = KVBLK * DQK * 2;
  int tid_ = threadIdx.x; asm volatile("" : "+v"(tid_));
  const int tid = tid_, wid = tid >> 6, lane = tid & 63, r32 = lane & 31, hi = lane >> 5;
  char* V_lds = lds; char* K_lds = lds + 2 * SHM_V;
  float* ws = (float*)(lds + 2 * SHM_V + 2 * SHM_KMAX) + wid * 64; float* li_l = ws; float* al_l = ws + 32;
  float m_reg = -1e30f, l_reg = 0; f32x16 o[4] = {}; bf16x8 qr[DQK / 16];
  const bf16_t* Qw = Qb + (long)(wid * QBLK + r32) * LDQ + hi * 8;
#pragma unroll
  for (int d0 = 0; d0 < DQK / 16; ++d0) qr[d0] = *reinterpret_cast<const bf16x8*>(Qw + d0 * 16);
  const int sr = tid >> 4, sc = (tid & 15) * 8, vst0 = v_st(sr, sc), vst1 = v_st(32 + sr, sc);
  const int kr64 = tid >> 3, kc64 = (tid & 7) * 8;
  const int vb0 = (int)(uintptr_t)V_lds + v_rd_base(lane);
  struct { bf16x8 vs0, vs1, ks0, ks1; } sr_[2];
#define SLOAD(i, k0) do { sr_[i].vs0 = *reinterpret_cast<const bf16x8*>(&Vh[(long)((k0) + sr) * LDV + sc]); sr_[i].vs1 = *reinterpret_cast<const bf16x8*>(&Vh[(long)((k0) + 32 + sr) * LDV + sc]); \
    if constexpr (DQK == 128) { sr_[i].ks0 = *reinterpret_cast<const bf16x8*>(&Kh[(long)((k0) + sr) * LDK + sc]); sr_[i].ks1 = *reinterpret_cast<const bf16x8*>(&Kh[(long)((k0) + 32 + sr) * LDK + sc]); } \
    else { sr_[i].ks0 = *reinterpret_cast<const bf16x8*>(&Kh[(long)((k0) + kr64) * LDK + kc64]); } } while (0)
#define SWRITE(b, i) do { *(bf16x8*)(V_lds + (b) * SHM_V + vst0) = sr_[i].vs0; *(bf16x8*)(V_lds + (b) * SHM_V + vst1) = sr_[i].vs1; \
    if constexpr (DQK == 128) { *(bf16x8*)(K_lds + (b) * SHM_K + kswz<128>(sr, sc * 2)) = sr_[i].ks0; *(bf16x8*)(K_lds + (b) * SHM_K + kswz<128>(32 + sr, sc * 2)) = sr_[i].ks1; } \
    else { *(bf16x8*)(K_lds + (b) * SHM_K + kswz<64>(kr64, kc64 * 2)) = sr_[i].ks0; } } while (0)
#define SWAIT() do { if constexpr (DQK == 128) asm volatile("s_waitcnt vmcnt(4)" ::: "memory"); else asm volatile("s_waitcnt vmcnt(3)" ::: "memory"); } while (0)
#define RESC(a) do { if (__any((a) < 1.f)) { if (hi == 0) al_l[r32] = (a); asm volatile("s_waitcnt lgkmcnt(0)" ::: "memory"); \
    _Pragma("unroll") for (int d = 0; d < 4; ++d) _Pragma("unroll") for (int r = 0; r < 16; ++r) o[d][r] *= al_l[crow(r, hi)]; } } while (0)
  f32x16 pA0, pA1, pB0, pB1; float mnA, mnB, alA, alB; bf16x8 pa0, pa1, pa2, pa3; const int NT = seq / KVBLK;
  constexpr int SE = 0, SO = 1;
  SLOAD(SE, 0); asm volatile("s_waitcnt vmcnt(0)" ::: "memory"); SWRITE(0, SE); __syncthreads();
  qkt<DQK>(pA0, pA1, K_lds, qr, r32, hi); partialSM<DQK>(pA0, pA1, m_reg, mnA, alA);
  SLOAD(SO, KVBLK); if (2 < NT) SLOAD(SE, 2 * KVBLK);
  SWAIT(); SWRITE(1, SO); __syncthreads();
  for (int j = 1; j + 1 < NT; j += 2) {
    SBAR(); qkt<DQK>(pB0, pB1, K_lds + SHM_K, qr, r32, hi);
    finishSM(pA0, pA1, alA, l_reg, pa0, pa1, pa2, pa3); SBAR();
    SLOAD(SO, (j + 2) * KVBLK); SBAR();
    pv_d0(o, vb0, pa0, pa1, pa2, pa3); partialSM<DQK>(pB0, pB1, m_reg, mnB, alB);
    __syncthreads(); SWAIT(); SWRITE(0, SE);
    RESC(alB); __syncthreads();
    SBAR(); qkt<DQK>(pA0, pA1, K_lds, qr, r32, hi);
    finishSM(pB0, pB1, alB, l_reg, pa0, pa1, pa2, pa3); SBAR();
    if (j + 3 < NT) SLOAD(SE, (j + 3) * KVBLK); SBAR();
    pv_d0(o, vb0 + (int)SHM_V, pa0, pa1, pa2, pa3); partialSM<DQK>(pA0, pA1, m_reg, mnA, alA);
    __syncthreads(); SWAIT(); SWRITE(1, SO);
    RESC(alA); __syncthreads();
  }
  SBAR(); qkt<DQK>(pB0, pB1, K_lds + SHM_K, qr, r32, hi);
  finishSM(pA0, pA1, alA, l_reg, pa0, pa1, pa2, pa3); SBAR();
  pv_d0(o, vb0, pa0, pa1, pa2, pa3); partialSM<DQK>(pB0, pB1, m_reg, mnB, alB);
  __syncthreads(); RESC(alB);
  finishSM(pB0, pB1, alB, l_reg, pa0, pa1, pa2, pa3); SBAR();
  pv_d0(o, vb0 + (int)SHM_V, pa0, pa1, pa2, pa3);
  if (hi == 0) li_l[r32] = l_reg; asm volatile("s_waitcnt lgkmcnt(0)" ::: "memory");
  float rli[16];
#pragma unroll
  for (int r = 0; r < 16; ++r) rli[r] = __builtin_amdgcn_rcpf(li_l[crow(r, hi)]);
  if constexpr (MODE == 0) {
    bf16_t* Ow = ea.O + (long)(wid * QBLK) * LDO;
#pragma unroll
    for (int r = 0; r < 16; ++r) { const int orow = crow(r, hi);
#pragma unroll
      for (int d0 = 0; d0 < 4; ++d0) Ow[(long)orow * LDO + d0 * 32 + r32] = (bf16_t)(cvtpk(o[d0][r] * rli[r], 0.f) & 0xffffu); }
  } else if constexpr (MODE == 1) {
    float* Sw = ea.S0 + (wid * QBLK) * 128;
#pragma unroll
    for (int r = 0; r < 16; ++r) { const int orow = crow(r, hi);
#pragma unroll
      for (int d0 = 0; d0 < 4; ++d0) Sw[orow * 128 + d0 * 32 + r32] = o[d0][r] * rli[r]; }
  } else {
    const volatile float* Sw = ea.S0 + (wid * QBLK) * 128;
    bf16_t* Ow = ea.O + (long)(wid * QBLK) * LDO;
    float gv[4];
#pragma unroll
    for (int d0 = 0; d0 < 4; ++d0) gv[d0] = ea.g[d0 * 32 + r32] * (1.0f - LAM_INIT);
#pragma unroll
    for (int r = 0; r < 16; ++r) { const int orow = crow(r, hi); float dv[4]; float ss = 0.f;
#pragma unroll
      for (int d0 = 0; d0 < 4; ++d0) { dv[d0] = Sw[orow * 128 + d0 * 32 + r32] - ea.lam * (o[d0][r] * rli[r]); ss += dv[d0] * dv[d0]; }
#pragma unroll
      for (int x = 1; x < 32; x <<= 1) ss += __shfl_xor(ss, x);
      const float rstd = 1.0f / sqrtf(ss * (1.0f / 128.0f) + EPS);
#pragma unroll
      for (int d0 = 0; d0 < 4; ++d0) Ow[(long)orow * LDO + d0 * 32 + r32] = (bf16_t)(cvtpk(dv[d0] * rstd * gv[d0], 0.f) & 0xffffu); }
  }
  __syncthreads();
#undef SLOAD
#undef SWRITE
#undef SWAIT
#undef RESC
}

typedef short v4i16_t __attribute__((ext_vector_type(4)));
#define PP_NEGM(dqk) ((dqk) == 64)
#ifndef PP_GRP
#define PP_GRP(w) ((w) >> 2)
#endif
constexpr int PP_NS = 4;
constexpr int PP_VOFF = PP_NS * 16384, PP_WSOFF = 2 * PP_NS * 16384, PP_LDS = PP_WSOFF + NW * 256;
#ifndef PP_THRL
#define PP_THRL 11.5f
#endif
constexpr float THRL = PP_THRL;
__device__ __forceinline__ int swap23(int k) { return (k & ~0xC) | ((k & 4) << 1) | ((k & 8) >> 1); }
#define PP_WAITBAR() asm volatile("s_waitcnt vmcnt(0) lgkmcnt(0)\n\ts_barrier" ::: "memory")
#define PP_WAITBAR_N(N) asm volatile("s_waitcnt vmcnt(%0) lgkmcnt(0)\n\ts_barrier" :: "n"(N) : "memory")
#define PP_BAR() asm volatile("s_waitcnt lgkmcnt(0)\n\ts_barrier" ::: "memory")
template <int DQK, int WHAT  > struct PPA {
  static constexpr int NQ = WHAT == 2 ? 0 : DQK / 8, NF = NQ + (WHAT >= 1 ? 16 : 0), PD = DQK == 128 ? 6 : 8, HOFF = 32 * DQK * 2;
  static constexpr int ops(int i) { return i < NQ ? 1 : 2; }
  static constexpr int newer(int i) { int n = 0; for (int k = i + 1; k < NF && k <= i + PD; ++k) n += ops(k); return n > 15 ? 15 : n; }
  template <int I> static __device__ __forceinline__ void load(bf16x8 (&F)[NF], const int (&ka)[DQK / 16], int va) {
    if constexpr (I < NQ) { constexpr int d0 = I >> 1, h = I & 1;
      asm volatile("ds_read_b128 %0, %1 offset:%2" : "=&v"(F[I]) : "v"(ka[d0]), "n"(h * HOFF)); }
    else { constexpr int x = I - NQ, ks = x >> 2, d = x & 3; s16x4 lo, hi;
      asm volatile("ds_read_b64_tr_b16 %0, %1 offset:%2" : "=&v"(lo) : "v"(va), "n"(v_rd_off(d, ks, 0)));
      asm volatile("ds_read_b64_tr_b16 %0, %1 offset:%2" : "=&v"(hi) : "v"(va), "n"(v_rd_off(d, ks, 1)));
      F[I] = (bf16x8){lo[0], lo[1], lo[2], lo[3], hi[0], hi[1], hi[2], hi[3]}; }
  }
  template <int I> static __device__ __forceinline__ void pre(bf16x8 (&F)[NF], const int (&ka)[DQK / 16], int va) {
    if constexpr (I < PD && I < NF) { load<I>(F, ka, va); pre<I + 1>(F, ka, va); }
  }
  template <int I> static __device__ __forceinline__ void step(f32x16& S0, f32x16& S1, f32x16 (&o)[4], const bf16x8 (&qr)[DQK / 16], const bf16x8 (&pa)[4], bf16x8 (&F)[NF], const int (&ka)[DQK / 16], int va, const f32x16& negm) {
    if constexpr (I < NF) {
      if constexpr (I + PD < NF) load<I + PD>(F, ka, va);
      asm volatile("s_waitcnt lgkmcnt(%1)" : "+v"(F[I]) : "n"(newer(I)));
      if constexpr (I < NQ) { constexpr int d0 = I >> 1;
        if constexpr ((I & 1) == 0) { if constexpr (d0 == 0) S0 = __builtin_amdgcn_mfma_f32_32x32x16_bf16(F[I], qr[d0], PP_NEGM(DQK) ? negm : f32x16{}, 0, 0, 0); else S0 = __builtin_amdgcn_mfma_f32_32x32x16_bf16(F[I], qr[d0], S0, 0, 0, 0); }
        else                        { if constexpr (d0 == 0) S1 = __builtin_amdgcn_mfma_f32_32x32x16_bf16(F[I], qr[d0], PP_NEGM(DQK) ? negm : f32x16{}, 0, 0, 0); else S1 = __builtin_amdgcn_mfma_f32_32x32x16_bf16(F[I], qr[d0], S1, 0, 0, 0); }
      } else { constexpr int x = I - NQ, ks = x >> 2, d = x & 3; o[d] = __builtin_amdgcn_mfma_f32_32x32x16_bf16(pa[ks], F[I], o[d], 0, 0, 0); }
      __builtin_amdgcn_sched_barrier(0);
      step<I + 1>(S0, S1, o, qr, pa, F, ka, va, negm);
    }
  }
};
template <int DQK, int WHAT, int NFV>
__device__ __forceinline__ void pp_seg_pre(bf16x8 (&F)[NFV], const int (&ka)[DQK / 16], int va) {
  static_assert(NFV == PPA<DQK, WHAT>::NF, "fragment array size");
  __builtin_amdgcn_sched_barrier(0);
  PPA<DQK, WHAT>::template pre<0>(F, ka, va);
  __builtin_amdgcn_sched_barrier(0);
}
template <int DQK, int WHAT, int NFV>
__device__ __forceinline__ void pp_seg_run(f32x16& S0, f32x16& S1, f32x16 (&o)[4], const bf16x8 (&qr)[DQK / 16], const bf16x8 (&pa)[4], bf16x8 (&F)[NFV], const int (&ka)[DQK / 16], int va, f32x16& lsum, const f32x16& negm) {
  static_assert(NFV == PPA<DQK, WHAT>::NF, "fragment array size");
  using P = PPA<DQK, WHAT>;
  __builtin_amdgcn_sched_barrier(0);
  P::template step<0>(S0, S1, o, qr, pa, F, ka, va, negm);
  if constexpr (WHAT >= 1) {
    bf16x8 ones; { const u32x4 w = {0x3f803f80u, 0x3f803f80u, 0x3f803f80u, 0x3f803f80u}; ones = __builtin_bit_cast(bf16x8, w); }
#pragma unroll
    for (int ks = 0; ks < 4; ++ks) lsum = __builtin_amdgcn_mfma_f32_32x32x16_bf16(pa[ks], ones, lsum, 0, 0, 0);
  }
}
template <int DQK, int LDQ, int LDK, int LDV, int LDO, int MODE>
__device__ __forceinline__ void attn_pp_body(const bf16_t* __restrict__ Qb, const bf16_t* __restrict__ Kh, const bf16_t* __restrict__ Vh, const EpiArgs ea, int seq, LAS char* lds, int tstart) {
  constexpr int SHM_K = KVBLK * DQK * 2, SHM_VV = KVBLK * DV * 2, NKP = DQK == 128 ? 2 : 1;
  int tid_ = threadIdx.x; asm volatile("" : "+v"(tid_));
  const int tid = tid_, wid = __builtin_amdgcn_readfirstlane(tid >> 6), lane = tid & 63, r32 = lane & 31, hi = lane >> 5, grp = PP_GRP(wid);
  LAS float* al_l = (LAS float*)(lds + PP_WSOFF) + wid * 64; LAS float* li_l = al_l + 32;
  int koff[NKP], voff[2];
#pragma unroll
  for (int i = 0; i < NKP; ++i) { const int o = (wid + 8 * i) * 1024 + lane * 16;
    if constexpr (DQK == 128) { const int row = o >> 8, cb = (o & 255) ^ ((row & 15) << 4); koff[i] = row * LDK + (cb >> 1); }
    else { const int row = o >> 7, cb = (o & 127) ^ (((row >> 1) & 7) << 4); koff[i] = row * LDK + (cb >> 1); } }
#pragma unroll
  for (int i = 0; i < 2; ++i) { const int o = (wid + 8 * i) * 1024 + lane * 16, sub = o >> 9, within = (o & 511) >> 1;
    const int kk = (sub >> 2) * 8 + (within >> 5), c = (sub & 3) * 32 + (within & 31), s_ = swap23(kk), p_ = s_ & 15;
    const int key = (s_ & ~15) + (p_ & 3) + ((p_ >> 2) & 1) * 8 + ((p_ >> 3) & 1) * 4; voff[i] = key * LDV + c; }
#define DMA_K(t, slot) do { _Pragma("unroll") for (int i_ = 0; i_ < NKP; ++i_) __builtin_amdgcn_global_load_lds((const unsigned*)(Kh + (size_t)(t) * KVBLK * LDK + koff[i_]), \
    (LAS unsigned*)(lds + (slot) * SHM_K + (wid + 8 * i_) * 1024), 16, 0, 0); } while (0)
#define DMA_V(t, slot) do { _Pragma("unroll") for (int i_ = 0; i_ < 2; ++i_) __builtin_amdgcn_global_load_lds((const unsigned*)(Vh + (size_t)(t) * KVBLK * LDV + voff[i_]), \
    (LAS unsigned*)(lds + PP_VOFF + (slot) * SHM_VV + (wid + 8 * i_) * 1024), 16, 0, 0); } while (0)
  const int NT = seq / KVBLK, TM = NT - 1;
  DMA_K(tstart & TM, 0); DMA_V(tstart & TM, 0); DMA_K((tstart + 1) & TM, 1); DMA_V((tstart + 1) & TM, 1); DMA_K((tstart + 2) & TM, 2);
  bf16x8 qr[DQK / 16];
  { const bf16_t* Qw = Qb + (long)(wid * QBLK + r32) * LDQ + hi * 8;
#pragma unroll
    for (int d0 = 0; d0 < DQK / 16; ++d0) qr[d0] = *reinterpret_cast<const bf16x8*>(Qw + d0 * 16); }
  float m_ref = 0.f; f32x16 o[4] = {}; f32x16 lsum = {}; f32x16 negm = {}; f32x16 S0, S1; bf16x8 pa[4] = {};
  const int ldsb = (int)(unsigned)(size_t)lds;
  const int vrb = ldsb + PP_VOFF + v_rd_base(lane);
  int kz[DQK / 16];
#pragma unroll
  for (int d0 = 0; d0 < DQK / 16; ++d0) kz[d0] = ldsb + kswz<DQK>(r32, d0 * 32 + hi * 16);
  PP_WAITBAR();
  if (grp == 1) PP_BAR();
#define PP_FADD(a, b) ((a) + (b))
#define PK8(P, BASE, OUT) do { const u32x4 w_ = {cvtpk(P[BASE + 0], P[BASE + 1]), cvtpk(P[BASE + 2], P[BASE + 3]), cvtpk(P[BASE + 4], P[BASE + 5]), cvtpk(P[BASE + 6], P[BASE + 7])}; OUT = __builtin_bit_cast(bf16x8, w_); } while (0)
#if defined(PROBE_B)
#define PROBE_B_CODE { float d_ = m_ref; _Pragma("unroll") for (int q_ = 0; q_ < 64; ++q_) d_ = __builtin_fmaf(d_, 1.0001f, 0.5f); asm volatile("" :: "v"(d_)); }
#else
#define PROBE_B_CODE
#endif
#define PP_SEG_B(j, FIRST, sm1, sp2) do { \
    if ((j) + 3 < NT) DMA_K((tstart + (j) + 3) & TM, sm1); \
    if ((j) + 2 < NT) DMA_V((tstart + (j) + 2) & TM, sp2); \
    float a = fmaxf(fmaxf(S0[0], S0[1]), S1[0]), b = fmaxf(fmaxf(S0[2], S0[3]), S1[1]); a = fmaxf(fmaxf(a, S1[2]), S1[3]); \
    _Pragma("unroll") for (int r = 4; r < 16; r += 4) { a = fmaxf(fmaxf(a, S0[r]), S0[r + 1]); b = fmaxf(fmaxf(b, S0[r + 2]), S0[r + 3]); a = fmaxf(fmaxf(a, S1[r]), S1[r + 1]); b = fmaxf(fmaxf(b, S1[r + 2]), S1[r + 3]); } \
    float rm = fmaxf(a, b); \
    { auto rr = __builtin_amdgcn_permlane32_swap(__float_as_uint(rm), __float_as_uint(rm), false, false); rm = fmaxf(__uint_as_float(rr[0]), __uint_as_float(rr[1])); } \
    if (!PP_NEGM(DQK)) rm -= m_ref;                                  \
    if (FIRST) { m_ref += rm; if (PP_NEGM(DQK)) { _Pragma("unroll") for (int r = 0; r < 16; ++r) { S0[r] -= rm; S1[r] -= rm; negm[r] = -m_ref; } } }     \
    else if (__any(rm > THRL)) {                                     \
      const float dl = fmaxf(rm, 0.f); m_ref += dl; \
      if (PP_NEGM(DQK)) { _Pragma("unroll") for (int r = 0; r < 16; ++r) { S0[r] -= dl; S1[r] -= dl; negm[r] = -m_ref; } } \
      const float al = __builtin_amdgcn_exp2f(-dl); \
      if (hi == 0) al_l[r32] = al; asm volatile("s_waitcnt lgkmcnt(0)" ::: "memory"); \
      _Pragma("unroll") for (int r = 0; r < 16; ++r) { const float f_ = al_l[crow(r, hi)]; lsum[r] *= f_; _Pragma("unroll") for (int d = 0; d < 4; ++d) o[d][r] *= f_; } } \
    _Pragma("unroll") for (int r = 0; r < 16; ++r) { S0[r] = __builtin_amdgcn_exp2f(PP_NEGM(DQK) ? S0[r] : S0[r] - m_ref); S1[r] = __builtin_amdgcn_exp2f(PP_NEGM(DQK) ? S1[r] : S1[r] - m_ref); } \
    PK8(S0, 0, pa[0]); PK8(S0, 8, pa[1]); PK8(S1, 0, pa[2]); PK8(S1, 8, pa[3]); \
    PROBE_B_CODE \
  } while (0)
  { bf16x8 F0[PPA<DQK, 0>::NF]; pp_seg_pre<DQK, 0>(F0, kz, vrb); pp_seg_run<DQK, 0>(S0, S1, o, qr, pa, F0, kz, vrb, lsum, negm); }
  PP_WAITBAR();
  bf16x8 F[PPA<DQK, 1>::NF];
  PP_SEG_B(0, true, PP_NS - 1, 2);
#pragma unroll
  for (int z = 0; z < DQK / 16; ++z) kz[z] += SHM_K;
  pp_seg_pre<DQK, 1>(F, kz, vrb);
  PP_BAR();
  int sj = 1;
  for (int j = 1; j < NT; ++j) {
    const int sm1 = (sj + PP_NS - 1) & (PP_NS - 1), sp1 = (sj + 1) & (PP_NS - 1), sp2 = (sj + 2) & (PP_NS - 1);
    pp_seg_run<DQK, 1>(S0, S1, o, qr, pa, F, kz, vrb + sm1 * SHM_VV, lsum, negm);
    PP_WAITBAR();
    PP_SEG_B(j, false, sm1, sp2);
#pragma unroll
    for (int z = 0; z < DQK / 16; ++z) kz[z] += (sp1 == 0) ? -(PP_NS - 1) * SHM_K : SHM_K;
    if (j + 1 < NT) pp_seg_pre<DQK, 1>(F, kz, vrb);
    PP_BAR();
    sj = sp1;
  }
#undef PP_SEG_B
#undef PK8
#undef PP_FADD
  { bf16x8 F2[PPA<DQK, 2>::NF]; const int vd = vrb + ((sj + PP_NS - 1) & (PP_NS - 1)) * SHM_VV; pp_seg_pre<DQK, 2>(F2, kz, vd); pp_seg_run<DQK, 2>(S0, S1, o, qr, pa, F2, kz, vd, lsum, negm); }
  asm volatile("" ::: "memory");
  if (grp == 0) PP_BAR();
  float rli[16];
#pragma unroll
  for (int r = 0; r < 16; ++r) rli[r] = __builtin_amdgcn_rcpf(lsum[r]);
  if constexpr (MODE == 0) {
    bf16_t* Ow = ea.O + (long)(wid * QBLK) * LDO;
#pragma unroll
    for (int r = 0; r < 16; ++r) { const int orow = crow(r, hi);
#pragma unroll
      for (int d0 = 0; d0 < 4; ++d0) Ow[(long)orow * LDO + d0 * 32 + r32] = (bf16_t)(cvtpk(o[d0][r] * rli[r], 0.f) & 0xffffu); }
  } else if constexpr (MODE == 1) {
    float* Sw = ea.S0 + (wid * QBLK) * 128;
#pragma unroll
    for (int r = 0; r < 16; ++r) { const int orow = crow(r, hi);
#pragma unroll
      for (int d0 = 0; d0 < 4; ++d0) Sw[orow * 128 + d0 * 32 + r32] = o[d0][r] * rli[r]; }
  } else {
    const volatile float* Sw = ea.S0 + (wid * QBLK) * 128;
    bf16_t* Ow = ea.O + (long)(wid * QBLK) * LDO;
    float gv[4];
#pragma unroll
    for (int d0 = 0; d0 < 4; ++d0) gv[d0] = ea.g[d0 * 32 + r32] * (1.0f - LAM_INIT);
#pragma unroll
    for (int r = 0; r < 16; ++r) { const int orow = crow(r, hi); float dv[4]; float ss = 0.f;
#pragma unroll
      for (int d0 = 0; d0 < 4; ++d0) { dv[d0] = Sw[orow * 128 + d0 * 32 + r32] - ea.lam * (o[d0][r] * rli[r]); ss += dv[d0] * dv[d0]; }
#pragma unroll
      for (int x = 1; x < 32; x <<= 1) ss += __shfl_xor(ss, x);
      const float rstd = 1.0f / sqrtf(ss * (1.0f / 128.0f) + EPS);
#pragma unroll
      for (int d0 = 0; d0 < 4; ++d0) Ow[(long)orow * LDO + d0 * 32 + r32] = (bf16_t)(cvtpk(dv[d0] * rstd * gv[d0], 0.f) & 0xffffu); }
  }
  PP_WAITBAR();
#undef DMA_K
#undef DMA_V
}
#undef SBAR
}

#define XB_TMO      128
#define XB_XCNT(j)  (256  + 64 * (j))
#define XB_XSUB(j)  (1280 + 64 * (j))
#define XB_XGEN(j)  (2304 + 64 * (j))
#define XB_TOP      3328
#define XB_TOPGEN   3392
#define XCD_BAR_WORDS 3456
#define XB_SPIN_CAP (1u << 18)

__device__ __forceinline__ unsigned xb_ld(unsigned* p)              { return __hip_atomic_load(p, __ATOMIC_RELAXED, __HIP_MEMORY_SCOPE_AGENT); }
__device__ __forceinline__ unsigned xb_add(unsigned* p, unsigned v) { return __hip_atomic_fetch_add(p, v, __ATOMIC_RELAXED, __HIP_MEMORY_SCOPE_AGENT); }
__device__ __forceinline__ unsigned xb_xcc_id() { return (unsigned)__builtin_amdgcn_s_getreg((3 << 11) | 20) & 0xFu; }
#define XB_SPIN(cond, bar) do { unsigned _sp = 0; while (cond) { __builtin_amdgcn_s_sleep(1); \
    if ((++_sp & 255u) == 0u) { if (xb_ld(&(bar)[XB_TMO])) break; if (_sp > XB_SPIN_CAP) { atomicAdd(&(bar)[XB_TMO], 1u); break; } } } } while (0)

struct XcdBarrier {
    unsigned* bar; unsigned x;
    volatile LAS unsigned* st;
};

__device__ __forceinline__ XcdBarrier xcd_barrier_post(unsigned* bar, volatile LAS unsigned* st) {
    XcdBarrier b; b.bar = bar; b.x = xb_xcc_id(); b.st = st;
    if (threadIdx.x == 0) (void)xb_add(&bar[XB_XCNT(b.x)], 1u);
    return b;
}
__device__ __forceinline__ void xcd_barrier_complete(unsigned* bar, unsigned x, unsigned& nloc, unsigned& nx) {
    const unsigned G = gridDim.x * gridDim.y * gridDim.z;
    unsigned sum, cnt, mine, sp = 0u;
    for (;;) {
        sum = 0u; cnt = 0u; mine = 0u;
#pragma unroll
        for (unsigned j = 0; j < 16; ++j) { const unsigned c = xb_ld(&bar[XB_XCNT(j)]); sum += c; cnt += (c > 0u) ? 1u : 0u; mine = (j == x) ? c : mine; }
        if (sum == G) break;
        __builtin_amdgcn_s_sleep(1);
        if ((++sp & 255u) == 0u) { if (xb_ld(&bar[XB_TMO])) break; if (sp > XB_SPIN_CAP) { atomicAdd(&bar[XB_TMO], 1u); break; } }
    }
    nloc = mine > 0u ? mine : 1u; nx = cnt > 0u ? cnt : 1u;
}

__device__ __forceinline__ void xcd_barrier(const XcdBarrier& b) {
    asm volatile("s_waitcnt vmcnt(0)" ::: "memory");
    __syncthreads();
    if (threadIdx.x == 0) {
        unsigned* bar = b.bar;
        __builtin_amdgcn_s_waitcnt(0);
        unsigned nloc = b.st[0], nx = b.st[1];
        if (nloc == 0u) { xcd_barrier_complete(bar, b.x, nloc, nx); b.st[0] = nloc; b.st[1] = nx; }
        const unsigned old = xb_add(&bar[XB_XSUB(b.x)], 1u);
        const unsigned gen = old / nloc;
        if (old + 1u == (gen + 1u) * nloc) {
            __builtin_amdgcn_fence(__ATOMIC_RELEASE, "agent");
            asm volatile("s_waitcnt vmcnt(0)" ::: "memory");
            const unsigned og = xb_add(&bar[XB_TOP], 1u);
            const unsigned tg = og / nx;
            if (og + 1u == (tg + 1u) * nx) xb_add(&bar[XB_TOPGEN], 1u);
            else XB_SPIN(xb_ld(&bar[XB_TOPGEN]) == tg, bar);
            __builtin_amdgcn_fence(__ATOMIC_ACQUIRE, "agent");
            xb_add(&bar[XB_XGEN(b.x)], 1u);
            asm volatile("s_waitcnt vmcnt(0)" ::: "memory");
        } else {
            XB_SPIN(xb_ld(&bar[XB_XGEN(b.x)]) == gen, bar);
            __builtin_amdgcn_fence(__ATOMIC_ACQUIRE, "agent");
            asm volatile("s_waitcnt vmcnt(0)" ::: "memory");
        }
    }
    __syncthreads();
}

constexpr int LDS_BYTES = 131072 + 8192;
#ifndef EN_MASK
#define EN_MASK 0xFFFF
#endif
constexpr int ENM = EN_MASK;
constexpr int NPH = 46;
struct Ctx { LAS unsigned char* lds; char* ldsg; int tid, lane, wave, G, bid, gw, NGW; };

__host__ __device__ inline bool phase_active(int ph) {
    if (ph == 0 || ph == NPH - 1) return true;
    const int i = (ph - 1) / 11, s = (ph - 1) % 11, kind = i & 3;
    if (s < 4 || s > 7) return true;
    const int nm = (kind == 0) ? 2 : (kind == 2 ? 4 : 3);
    return (s - 4) < nm;
}

#ifndef PROBE_DUP
#define PROBE_DUP 0
#endif
__host__ __device__ inline bool probe_dup(int ph) {
    if (ph == 0) return PROBE_DUP == 6;
    if (ph == NPH - 1) return false;
    const int i = (ph - 1) / 11, s = (ph - 1) % 11, kind = i & 3;
    if (PROBE_DUP == 1) return s == 1 || s == 9;
    if (PROBE_DUP == 2) return s == 0 || s == 3 || s == 8;
    if (PROBE_DUP == 3) return kind == 1 && s == 5;
    if (PROBE_DUP == 4) return kind == 2 && s == 6;
    if (PROBE_DUP == 5) return s == 4 && kind != 0;
    if (PROBE_DUP == 7) return i == 0 && s == 2;
    return false;
}
__device__ __forceinline__ int dest_row(int mode, int n0) {
    if (mode == 0) return n0;
    if (mode == 1) { const int h = n0 >= DFF ? 1 : 0; const int j = n0 - h * DFF; return (j >> 7) * 256 + h * 128 + (j & 127); }
    if (n0 < 1024) return 2048 + n0;
    const int h = n0 >= 2048 ? 1 : 0; const int j = n0 - 1024 - h * 1024; return (j >> 7) * 256 + h * 128 + (j & 127);
}
__device__ __forceinline__ void transpose_item(const float* W, int K, int N, bf16_t* WT, int k0, int n0, int dn0, LAS float* scr, int lane) {
#pragma unroll 8
    for (int i = 0; i < 32; ++i) { const int kk = 2 * i + (lane >> 5); scr[kk * 33 + (lane & 31)] = W[(size_t)(k0 + kk) * N + n0 + (lane & 31)]; }
    LDS_WAIT(); asm volatile("" ::: "memory");
    const int c = lane & 7;
#pragma unroll
    for (int j = 0; j < 4; ++j) { const int n = (lane >> 3) + 8 * j; const LAS float* s = scr + (8 * c) * 33 + n;
        v4u o; o.x = cvt_pk_bf16(s[0 * 33], s[1 * 33]); o.y = cvt_pk_bf16(s[2 * 33], s[3 * 33]); o.z = cvt_pk_bf16(s[4 * 33], s[5 * 33]); o.w = cvt_pk_bf16(s[6 * 33], s[7 * 33]);
        *(v4u*)(WT + (size_t)(dn0 + n) * K + k0 + 8 * c) = o; }
    LDS_WAIT(); asm volatile("" ::: "memory");
}
template <class AP> __device__ __forceinline__ void prologue(const Ctx& F, AP a) {
    unsigned char* ws = a->ws;
    {
        LAS float* cact = (LAS float*)F.lds; LAS float* red = cact + 2048;
        const float* c = a->in[1];
        for (int u = F.tid; u < 2048; u += NTHR) cact[u] = silu_f(c[u]);
        __syncthreads();
        float* MODV = (float*)(ws + WS_MODV);
        for (int item = F.bid; item < 144; item += F.G) {
            const int i = item / 36, cb = item % 36;
            const float* W = a->in[2] + (size_t)i * 1024 * 9216 + cb * 256 + 4 * F.lane;
            f32x4 a0 = {0.f, 0.f, 0.f, 0.f}, a1 = a0;
            const int kbeg = F.wave * 128;
#pragma unroll 8
            for (int k = kbeg; k < kbeg + 128; ++k) { const f32x4 w = *(const f32x4*)(W + (size_t)k * 9216); a0 += w * cact[k]; a1 += w * cact[1024 + k]; }
            *(LAS f32x4*)(red + (F.wave * 2 + 0) * 256 + 4 * F.lane) = a0;
            *(LAS f32x4*)(red + (F.wave * 2 + 1) * 256 + 4 * F.lane) = a1;
            __syncthreads();
            { const int b = F.tid >> 8, col = F.tid & 255; float s = a->in[3][i * 9216 + cb * 256 + col];
#pragma unroll
              for (int w = 0; w < 8; ++w) s += red[(w * 2 + b) * 256 + col];
              MODV[(size_t)(i * 2 + b) * 9216 + cb * 256 + col] = s; }
            __syncthreads();
        }
        __syncthreads();
    }
    if (F.bid == 0) { unsigned* bw = (unsigned*)(ws + WS_BAR); int t0 = threadIdx.x; asm volatile("" : "+v"(t0)); for (int u = t0; u < XCD_BAR_WORDS; u += NTHR) bw[u] = 0u; }
    {
        float* R1 = (float*)(ws + WS_ROPE1); float* AX = (float*)(ws + WS_AXR);
        const int gt = F.gw * 64 + F.lane, NT = F.NGW * 64;
        for (int idx = gt; idx < SEQ * 8; idx += NT) { const int t = idx >> 3, j = idx & 7; float c, s; sincos_acc((float)t * INV1[j], c, s); R1[t * 16 + j] = c; R1[t * 16 + 8 + j] = s; }
        for (int idx = gt; idx < 256 * 32; idx += NT) { const int p = idx >> 5, f = idx & 31; float c, s; sincos_acc((float)p * INV2[f], c, s); AX[p * 64 + f] = c; AX[p * 64 + 32 + f] = s; }
    }
    {
        LAS float* scr = (LAS float*)(F.lds + F.wave * 16384);
        int base = 0;
        for (int mat = 0; mat < 26; ++mat) {
            const float* src; bf16_t* dst; int K, N, mode = 0;
            if (mat < 8)       { src = a->in[5] + (size_t)mat * D * 2 * DFF; dst = (bf16_t*)(ws + WS_WGU + (size_t)mat * SZ_WGU1); K = D; N = 2 * DFF; mode = 1; }
            else if (mat < 16) { src = a->in[6] + (size_t)(mat - 8) * DFF * D; dst = (bf16_t*)(ws + WS_WDN + (size_t)(mat - 8) * SZ_WDN1); K = DFF; N = D; }
            else if (mat < 20) { src = a->in[7] + (size_t)(mat - 16) * 65536; dst = (bf16_t*)(ws + WS_WPOOL) + (size_t)(mat - 16) * 65536; K = 256; N = 256; }
            else if (mat == 20) { src = a->in[9];  dst = (bf16_t*)(ws + WS_WDQKV); K = D; N = 3072; }
            else if (mat == 21) { src = a->in[12]; dst = (bf16_t*)(ws + WS_WDO);   K = D; N = D; }
            else if (mat == 22) { src = a->in[13]; dst = (bf16_t*)(ws + WS_WGQKV); K = D; N = 1536; }
            else if (mat == 23) { src = a->in[16]; dst = (bf16_t*)(ws + WS_WGO);   K = D; N = D; }
            else if (mat == 24) { src = a->in[17]; dst = (bf16_t*)(ws + WS_WCIN);  K = D; N = 3072; mode = 2; }
            else                { src = a->in[19]; dst = (bf16_t*)(ws + WS_WCOUT); K = D; N = D; }
            const int nblk = N / 32, nitems = (K / 64) * nblk;
            int first = (F.gw - base) % F.NGW; if (first < 0) first += F.NGW;
            for (int it = first; it < nitems; it += F.NGW) { const int kb = it / nblk, nb = it % nblk; transpose_item(src, K, N, dst, kb * 64, nb * 32, dest_row(mode, nb * 32), scr, F.lane); }
            base = (base + nitems) % F.NGW;
        }
    }
}

template <bool FINAL, bool XF32>
__device__ __forceinline__ void norm_phase(const Ctx& F, const void* xv, bf16_t* xn, float* xo, const float* g, const float* sh, const float* sc) {
    for (int b = 0; b < BATCH; ++b) {
        f32x4 A[4], Bv[4];
#pragma unroll
        for (int j = 0; j < 4; ++j) { const int col = 4 * F.lane + 256 * j; A[j] = *(const f32x4*)(g + col);
            if (!FINAL) { A[j] = A[j] * (*(const f32x4*)(sc + (size_t)b * 9216 + col) + 1.0f); Bv[j] = *(const f32x4*)(sh + (size_t)b * 9216 + col); } }
        for (int m0 = b * SEQ + F.gw; m0 < (b + 1) * SEQ; m0 += 2 * F.NGW) {
            f32x4 v[2][4]; float s[2] = {0.f, 0.f};
#pragma unroll
            for (int q = 0; q < 2; ++q) { const size_t m = (size_t)(m0 + q * F.NGW);
                if (XF32) { const f32x4* xr = (const f32x4*)((const float*)xv + m * D) + F.lane;
#pragma unroll
                    for (int j = 0; j < 4; ++j) v[q][j] = xr[64 * j];
                } else { const v2u* xr = (const v2u*)((const bf16_t*)xv + m * D) + F.lane;
#pragma unroll
                    for (int j = 0; j < 4; ++j) v[q][j] = half4_to_f32(xr[64 * j]); } }
#pragma unroll
            for (int q = 0; q < 2; ++q)
#pragma unroll
                for (int j = 0; j < 4; ++j) s[q] += (v[q][j].x * v[q][j].x + v[q][j].y * v[q][j].y) + (v[q][j].z * v[q][j].z + v[q][j].w * v[q][j].w);
#pragma unroll
            for (int q = 0; q < 2; ++q) { const size_t m = (size_t)(m0 + q * F.NGW);
                const float rstd = 1.0f / sqrtf(wave_sum(s[q]) * (1.0f / D) + EPS);
                if (FINAL) { f32x4* o = (f32x4*)(xo + m * D) + F.lane;
#pragma unroll
                    for (int j = 0; j < 4; ++j) o[64 * j] = v[q][j] * rstd * A[j];
                } else { v2u* o = (v2u*)(xn + m * D) + F.lane;
#pragma unroll
                    for (int j = 0; j < 4; ++j) { const f32x4 h = v[q][j] * rstd * A[j] + Bv[j]; v2u w; w.x = cvt_pk_bf16(h.x, h.y); w.y = cvt_pk_bf16(h.z, h.w); o[64 * j] = w; } } }
        }
    }
}
__device__ __forceinline__ void unpack_bf8(const v4u w, float (&f)[8]) { f[0] = bf_lo(w.x); f[1] = bf_hi(w.x); f[2] = bf_lo(w.y); f[3] = bf_hi(w.y); f[4] = bf_lo(w.z); f[5] = bf_hi(w.z); f[6] = bf_lo(w.w); f[7] = bf_hi(w.w); }
__device__ __forceinline__ void pooldiff_phase(const Ctx& F, const bf16_t* xn, bf16_t* pd) {
    const int gt = F.gw * 64 + F.lane, NT = F.NGW * 64;
    for (int task = gt; task < (M / 32) * 128; task += NT) {
        const int c8 = task & 127, m0 = (task >> 7) * 32, t0 = m0 & (SEQ - 1), b0 = m0 - t0, hw = 1 << (c8 >> 5);
        const bf16_t* col = xn + (size_t)b0 * D + c8 * 8;
        float acc[8] = {0.f, 0.f, 0.f, 0.f, 0.f, 0.f, 0.f, 0.f};
        for (int d = -8; d < 8; ++d) { const int r = t0 + d; if (d >= -hw && d < hw && r >= 0 && r < SEQ) { float f[8]; unpack_bf8(*(const v4u*)(col + (size_t)r * D), f);
#pragma unroll
                for (int e = 0; e < 8; ++e) acc[e] += f[e]; } }
        for (int i = 0; i < 32; ++i) { const int t = t0 + i;
            const int lo = t - hw < 0 ? 0 : t - hw, hi = t + hw > SEQ ? SEQ : t + hw; const float inv = 1.0f / (float)(hi - lo);
            float sf[8]; unpack_bf8(*(const v4u*)(col + (size_t)t * D), sf);
            v4u o; o.x = cvt_pk_bf16(acc[0] * inv - sf[0], acc[1] * inv - sf[1]); o.y = cvt_pk_bf16(acc[2] * inv - sf[2], acc[3] * inv - sf[3]);
            o.z = cvt_pk_bf16(acc[4] * inv - sf[4], acc[5] * inv - sf[5]); o.w = cvt_pk_bf16(acc[6] * inv - sf[6], acc[7] * inv - sf[7]);
            *(v4u*)(pd + (size_t)(b0 + t) * D + c8 * 8) = o;
            if (t - hw >= 0) { float f[8]; unpack_bf8(*(const v4u*)(col + (size_t)(t - hw) * D), f);
#pragma unroll
                for (int e = 0; e < 8; ++e) acc[e] -= f[e]; }
            if (t + hw < SEQ) { float f[8]; unpack_bf8(*(const v4u*)(col + (size_t)(t + hw) * D), f);
#pragma unroll
                for (int e = 0; e < 8; ++e) acc[e] += f[e]; }
        }
    }
}
__device__ __forceinline__ void conv_phase(const Ctx& F, const bf16_t* z, const bf16_t* gbuf, const float* wc, bf16_t* ca) {
    const int gt = F.gw * 64 + F.lane, NT = F.NGW * 64;
    for (int task = gt; task < (M / 32) * 128; task += NT) {
        const int c8 = task & 127, m0 = (task >> 7) * 32, t0 = m0 & (SEQ - 1);
        float w0[8], w1[8], w2[8];
#pragma unroll
        for (int e = 0; e < 8; ++e) { w0[e] = wc[c8 * 8 + e]; w1[e] = wc[D + c8 * 8 + e]; w2[e] = wc[2 * D + c8 * 8 + e]; }
        const v4u zero = {0u, 0u, 0u, 0u};
        float zm[8], z0[8], zp[8], gv[8];
        unpack_bf8(t0 > 0 ? *(const v4u*)(z + (size_t)(m0 - 1) * D + c8 * 8) : zero, zm);
        unpack_bf8(*(const v4u*)(z + (size_t)m0 * D + c8 * 8), z0);
        for (int i = 0; i < 32; ++i) { const int m = m0 + i, t = t0 + i;
            unpack_bf8(t < SEQ - 1 ? *(const v4u*)(z + (size_t)(m + 1) * D + c8 * 8) : zero, zp);
            unpack_bf8(*(const v4u*)(gbuf + (size_t)m * D + c8 * 8), gv);
            float r[8];
#pragma unroll
            for (int e = 0; e < 8; ++e) r[e] = gv[e] * (w0[e] * zm[e] + w1[e] * z0[e] + w2[e] * zp[e]);
            v4u o; o.x = cvt_pk_bf16(r[0], r[1]); o.y = cvt_pk_bf16(r[2], r[3]); o.z = cvt_pk_bf16(r[4], r[5]); o.w = cvt_pk_bf16(r[6], r[7]);
            *(v4u*)(ca + (size_t)m * D + c8 * 8) = o;
#pragma unroll
            for (int e = 0; e < 8; ++e) { zm[e] = z0[e]; z0[e] = zp[e]; }
        }
    }
}
__device__ __forceinline__ void qknorm_phase(const Ctx& F, bf16_t* Q, bf16_t* K, const float* qg, const float* kg, const float* ax) {
    const int gt = F.gw * 64 + F.lane, NT = F.NGW * 64, sub = F.lane & 15;
    float gq[8], gk[8];
#pragma unroll
    for (int e = 0; e < 8; ++e) { gq[e] = qg[sub * 8 + e]; gk[e] = kg[sub * 8 + e]; }
    const bool second = (sub & 4) != 0;
    for (int m = gt >> 4; m < M; m += NT >> 4) {
        const int t = m & (SEQ - 1);
        const int pos = sub < 8 ? (t >> 6) : (t & 63);
        const float* cs = ax + pos * 64 + (sub & 3) * 8;
        float c[8], s[8];
#pragma unroll
        for (int e = 0; e < 8; ++e) { c[e] = cs[e]; s[e] = cs[32 + e]; }
#pragma unroll 2
        for (int hh = 0; hh < 10; ++hh) {
            bf16_t* p = hh < 8 ? Q + (size_t)m * 1024 + hh * 128 + sub * 8 : K + (size_t)m * 256 + (hh - 8) * 128 + sub * 8;
            const v4u w = *(const v4u*)p;
            float v[8] = {bf_lo(w.x), bf_hi(w.x), bf_lo(w.y), bf_hi(w.y), bf_lo(w.z), bf_hi(w.z), bf_lo(w.w), bf_hi(w.w)};
            float ss = 0.f;
#pragma unroll
            for (int e = 0; e < 8; ++e) ss += v[e] * v[e];
            ss += __shfl_xor(ss, 1); ss += __shfl_xor(ss, 2); ss += __shfl_xor(ss, 4); ss += __shfl_xor(ss, 8);
            const float rstd = 1.0f / sqrtf(ss * (1.0f / 128.0f) + EPS);
#pragma unroll
            for (int e = 0; e < 8; ++e) v[e] = v[e] * rstd * (hh < 8 ? gq[e] : gk[e]);
            const float qs = hh < 8 ? 0.12751743074602467f : 1.0f;
            float o[8];
#pragma unroll
            for (int e = 0; e < 8; ++e) { const float pv = __shfl_xor(v[e], 4); o[e] = (second ? (v[e] * c[e] + pv * s[e]) : (v[e] * c[e] - pv * s[e])) * qs; }
            v4u ow; ow.x = cvt_pk_bf16(o[0], o[1]); ow.y = cvt_pk_bf16(o[2], o[3]); ow.z = cvt_pk_bf16(o[4], o[5]); ow.w = cvt_pk_bf16(o[6], o[7]);
            *(v4u*)p = ow;
        }
    }
}

__global__ void __launch_bounds__(NTHR, 2) fwd_kernel(Args a) {
    extern __shared__ __attribute__((aligned(16))) unsigned char lds_raw[];
    const int ph_lo = a.ph_lo, ph_hi = a.ph_hi;
#define XB_ST() ((volatile LAS unsigned*)((LAS unsigned char*)lds_raw + LDS_BYTES - 64))
    if (threadIdx.x == 0) { XB_ST()[0] = 0u; XB_ST()[1] = 0u; }
    __syncthreads();
#define PHASE_SETUP() \
        KArgs ap = (KArgs)__builtin_amdgcn_kernarg_segment_ptr();     \
        asm volatile("" : "+s"(ap)); \
        unsigned char* ws = ap->ws; \
        float* MODV = (float*)(ws + WS_MODV); \
        bf16_t* XN = (bf16_t*)(ws + WS_XN); bf16_t* ACT = (bf16_t*)(ws + WS_ACT); \
        bf16_t* QB = (bf16_t*)(ws + WS_Q); bf16_t* KB = (bf16_t*)(ws + WS_K); bf16_t* VB = (bf16_t*)(ws + WS_V); bf16_t* AO = (bf16_t*)(ws + WS_AO); \
        float* X = ap->out; bf16_t* XB = (bf16_t*)(ws + WS_XB); \
        Ctx F;                                                      \
        F.lds = (LAS unsigned char*)lds_raw; F.ldsg = (char*)lds_raw; \
        { int t_ = threadIdx.x; asm volatile("" : "+v"(t_)); F.tid = t_; } \
        F.lane = F.tid & 63; F.wave = __builtin_amdgcn_readfirstlane(F.tid >> 6); \
        F.G = gridDim.x; F.bid = blockIdx.x; F.gw = F.bid * NWAVES + F.wave; F.NGW = F.G * NWAVES; \
        (void)MODV; (void)XN; (void)ACT; (void)QB; (void)KB; (void)VB; (void)AO; (void)X; (void)XB;
#define SEAM(PH, MORE) do { if (MORE) { \
            const bool one_launch_ = (ap->ph_lo == 0 && ap->ph_hi == NPH); \
            if (one_launch_ && (PH) > 0) { XcdBarrier xb; xb.bar = (unsigned*)(ap->ws + WS_BAR); xb.x = xb_xcc_id(); xb.st = XB_ST(); xcd_barrier(xb); } \
            else { cg::this_grid().sync(); \
                if (one_launch_) { unsigned* bw = (unsigned*)(ap->ws + WS_BAR); if (threadIdx.x == 0) (void)xb_add(&bw[XB_XCNT(xb_xcc_id())], 1u); } } } } while (0)
    int ph = ph_lo;
    if (ph == 0 && ph < ph_hi) { PHASE_SETUP(); if constexpr (ENM & 1) prologue(F, ap); SEAM(0, 1 < ph_hi); ph = 1; }
    int rep = 0; (void)rep;
    for (; ph < ph_hi; ++ph) {
        if (!phase_active(ph)) continue;
        PHASE_SETUP();
        if (false) {}
        else if (ph == NPH - 1) { if constexpr (ENM & 2) norm_phase<true, false>(F, XB, nullptr, X, ap->in[20], nullptr, nullptr); }
        else {
            const int i = (ph - 1) / 11, s = (ph - 1) % 11, kind = i & 3;
            const float* mv = MODV + (size_t)i * 2 * 9216;
            if (s == 0 || s == 3 || s == 8) { if constexpr (ENM & 2) {
                const int j = s == 0 ? 0 : (s == 3 ? 1 : 2);
                if (i == 0 && s == 0) norm_phase<false, true>(F, ap->in[0], XN, nullptr, ap->in[4] + (size_t)(i * 3 + j) * D, mv + (3 * j) * D, mv + (3 * j + 1) * D);
                else norm_phase<false, false>(F, XB, XN, nullptr, ap->in[4] + (size_t)(i * 3 + j) * D, mv + (3 * j) * D, mv + (3 * j + 1) * D); }
            } else if (s == 1 || s == 9) { if constexpr (ENM & 4) {
                const int f = s == 1 ? 0 : 1;
                pg8::Gemm g{XN, (const bf16_t*)(ws + WS_WGU + (size_t)(i * 2 + f) * SZ_WGU1), M, 2 * DFF, D, D, D, 0};
                pg8::StaticOrder S; S.init(M, 2 * DFF, F.G, F.bid);
                pg8::EpiSwiglu E{ACT, DFF};
                pg8::gemm_phase<pg8::EpiSwiglu, pg8::StaticOrder, true, true>(F.lds, g, S, E); }
            } else if (s == 2 || s == 10) { if constexpr (ENM & 8) {
                const int f = s == 2 ? 0 : 1;
                pg8::Gemm g{ACT, (const bf16_t*)(ws + WS_WDN + (size_t)(i * 2 + f) * SZ_WDN1), M, D, DFF, DFF, DFF, 0};
                pg8::StaticOrder S; S.init(M, D, F.G, F.bid);
                pg8::EpiRes E{(i == 0 && s == 2) ? (const void*)ap->in[0] : (const void*)XB, (i == 0 && s == 2) ? 1 : 0, XB, mv + (f == 0 ? 2 : 8) * D, nullptr, 0.5f};
                pg8::gemm_phase<pg8::EpiRes, pg8::StaticOrder, true, true>(F.lds, g, S, E); }
            } else if (kind == 0) { if constexpr (ENM & 16) {
                if (s == 4) pooldiff_phase(F, XN, AO);
                else { pg8::Gemm g{AO, (const bf16_t*)(ws + WS_WPOOL), M, D, 256, D, 256, 512};
                    pg8::StaticOrder S; S.init(M, D, F.G, F.bid);
                    pg8::EpiRes E{XB, 0, XB, mv + 5 * D, ap->in[8], 1.0f};
                    pg8::gemm_phase<pg8::EpiRes, pg8::StaticOrder, true, true>(F.lds, g, S, E); }
            } } else if (kind == 1) { if constexpr (ENM & 32) {
                if (s == 4) { pg8::Gemm g{XN, (const bf16_t*)(ws + WS_WDQKV), M, 3072, D, D, D, 0};
                    pg8::StaticOrder S; S.init(M, 3072, F.G, F.bid);
                    pg8::EpiDiffQkv E{ws, (const float*)(ws + WS_ROPE1)};
                    pg8::gemm_phase<pg8::EpiDiffQkv, pg8::StaticOrder, true, true>(F.lds, g, S, E);
                } else if (s == 5) {
                    const float* lm = ap->in[10]; float d01 = 0.f, d23 = 0.f;
                    for (int e = 0; e < 64; ++e) { d01 += lm[e] * lm[64 + e]; d23 += lm[128 + e] * lm[192 + e]; }
                    const float lam = expf(d01) - expf(d23) + LAM_INIT;
                    float* S0 = (float*)(ws + WS_S0) + (size_t)F.bid * 256 * 128;
                    for (int u = F.bid; u < BATCH * 8 * 64; u += F.G) {
                        const int it = u / F.G, xcd = F.bid & 7, idx = F.bid >> 3;
                        const int bh = (F.G == 256) ? it * 4 + (xcd >> 1) : (u >> 6), qb = (F.G == 256) ? (xcd & 1) * 32 + idx : (u & 63), b = bh >> 3, h = bh & 7;
                        const size_t qrow = (size_t)b * SEQ + (size_t)qb * 256, krow = (size_t)b * SEQ;
                        att::EpiArgs ea{AO + qrow * 1024 + h * 128, S0, ap->in[11], lam};
                        att::attn_pp_body<64, 1024, 1024, 1024, 1024, 1>(QB + qrow * 1024 + (2 * h) * 64, KB + krow * 1024 + (2 * h) * 64, VB + krow * 1024 + h * 128, ea, SEQ, (LAS char*)F.lds, (F.bid >> 3) * 2);
                        att::attn_pp_body<64, 1024, 1024, 1024, 1024, 2>(QB + qrow * 1024 + (2 * h + 1) * 64, KB + krow * 1024 + (2 * h + 1) * 64, VB + krow * 1024 + h * 128, ea, SEQ, (LAS char*)F.lds, (F.bid >> 3) * 2);
                    }
                } else { pg8::Gemm g{AO, (const bf16_t*)(ws + WS_WDO), M, D, D, D, D, 0};
                    pg8::StaticOrder S; S.init(M, D, F.G, F.bid);
                    pg8::EpiRes E{XB, 0, XB, mv + 5 * D, nullptr, 1.0f};
                    pg8::gemm_phase<pg8::EpiRes, pg8::StaticOrder, true, true>(F.lds, g, S, E); }
            } } else if (kind == 2) { if constexpr (ENM & 64) {
                if (s == 4) { pg8::Gemm g{XN, (const bf16_t*)(ws + WS_WGQKV), M, 1536, D, D, D, 0};
                    pg8::StaticOrder S; S.init(M, 1536, F.G, F.bid);
                    pg8::EpiGqaQkv E{ws};
                    pg8::gemm_phase<pg8::EpiGqaQkv, pg8::StaticOrder, true, true>(F.lds, g, S, E);
                } else if (s == 5) qknorm_phase(F, QB, KB, ap->in[14], ap->in[15], (const float*)(ws + WS_AXR));
                else if (s == 6) {
                    for (int u = F.bid; u < BATCH * 8 * 64; u += F.G) {
                        const int bh = u >> 6, qb = u & 63, b = bh >> 3, h = bh & 7, kvh = h >> 2;
                        const size_t qrow = (size_t)b * SEQ + (size_t)qb * 256, krow = (size_t)b * SEQ;
                        att::EpiArgs ea{AO + qrow * 1024 + h * 128, nullptr, nullptr, 0.f};
                        att::attn_pp_body<128, 1024, 256, 256, 1024, 0>(QB + qrow * 1024 + h * 128, KB + krow * 256 + kvh * 128, VB + krow * 256 + kvh * 128, ea, SEQ, (LAS char*)F.lds, (F.bid >> 3) * 2);
                    }
                } else { pg8::Gemm g{AO, (const bf16_t*)(ws + WS_WGO), M, D, D, D, D, 0};
                    pg8::StaticOrder S; S.init(M, D, F.G, F.bid);
                    pg8::EpiRes E{XB, 0, XB, mv + 5 * D, nullptr, 1.0f};
                    pg8::gemm_phase<pg8::EpiRes, pg8::StaticOrder, true, true>(F.lds, g, S, E); }
            } } else { if constexpr (ENM & 128) {
                if (s == 4) { pg8::Gemm g{XN, (const bf16_t*)(ws + WS_WCIN), M, 3072, D, D, D, 0};
                    pg8::StaticOrder S; S.init(M, 3072, F.G, F.bid);
                    pg8::EpiConvIn E{QB, KB};
                    pg8::gemm_phase<pg8::EpiConvIn, pg8::StaticOrder, true, true>(F.lds, g, S, E);
                } else if (s == 5) conv_phase(F, QB, KB, ap->in[18], AO);
                else { pg8::Gemm g{AO, (const bf16_t*)(ws + WS_WCOUT), M, D, D, D, D, 0};
                    pg8::StaticOrder S; S.init(M, D, F.G, F.bid);
                    pg8::EpiRes E{XB, 0, XB, mv + 5 * D, nullptr, 1.0f};
                    pg8::gemm_phase<pg8::EpiRes, pg8::StaticOrder, true, true>(F.lds, g, S, E); }
            } }
        }
        bool more = false;
        for (int q = ph + 1; q < ph_hi; ++q) if (phase_active(q)) { more = true; break; }
#if PROBE_DUP
        if (rep == 0 && probe_dup(ph)) { rep = 1; --ph; more = true; } else rep = 0;
#endif
        SEAM(ph, more);
#if PROBE_DUP == 8
        if (ph == 1) { for (int q = 0; q < 40; ++q) { XcdBarrier xb; xb.bar = (unsigned*)(ap->ws + WS_BAR); xb.x = xb_xcc_id(); xb.st = XB_ST(); xcd_barrier(xb); } }
#endif
    }
}

extern "C" void kernel_launch(void* const* d_in, const int* in_sizes, int n_in, void* d_out, int out_size, void* d_ws, size_t ws_size, hipStream_t stream) {
    static int grid = 0;
    if (grid == 0) {
        if (n_in != 21 || in_sizes[0] != M * D || out_size != M * D || ws_size < WS_END) {
            fprintf(stderr, "kernel_launch: shape mismatch n_in %d in0 %d out %d ws %zu (need %zu)\n", n_in, n_in > 0 ? in_sizes[0] : -1, out_size, ws_size, (size_t)WS_END); grid = -1; return; }
        int dev = 0, cus = 0, per_cu = 0;
        (void)hipGetDevice(&dev); (void)hipDeviceGetAttribute(&cus, hipDeviceAttributeMultiprocessorCount, dev);
        if (hipFuncSetAttribute((const void*)fwd_kernel, hipFuncAttributeMaxDynamicSharedMemorySize, LDS_BYTES) != hipSuccess) { fprintf(stderr, "kernel_launch: hipFuncSetAttribute failed\n"); grid = -1; return; }
        if (hipOccupancyMaxActiveBlocksPerMultiprocessor(&per_cu, (const void*)fwd_kernel, NTHR, LDS_BYTES) != hipSuccess || per_cu < 1) { fprintf(stderr, "kernel_launch: occupancy query gave %d\n", per_cu); per_cu = 1; }
        (void)hipGetLastError();
        grid = cus * per_cu;
        fprintf(stderr, "kernel_launch: grid %d (cus %d x %d)\n", grid, cus, per_cu);
    }
    if (grid < 0) return;
    Args a{};
    for (int i = 0; i < 21; ++i) a.in[i] = (const float*)d_in[i];
    a.out = (float*)d_out; a.ws = (unsigned char*)d_ws;
#if MK_ONE_LAUNCH
    a.ph_lo = 0; a.ph_hi = NPH;
    void* args[] = {&a};
    hipError_t e = hipLaunchCooperativeKernel((const void*)fwd_kernel, dim3(grid), dim3(NTHR), args, LDS_BYTES, stream);
    if (e != hipSuccess) fprintf(stderr, "cooperative launch failed: %s (grid %d)\n", hipGetErrorString(e), grid);
#else
    for (int ph = 0; ph < NPH; ++ph) {
        if (!phase_active(ph)) continue;
        a.ph_lo = ph; a.ph_hi = ph + 1;
        hipLaunchKernelGGL(fwd_kernel, dim3(grid), dim3(NTHR), LDS_BYTES, stream, a);
    }
#endif
}
```
